# Optimizing an MI355X kernel written in HIP

```python
import math
import jax, jax.numpy as jnp
from jax import lax
import numpy as np

D_MODEL = 1024
BATCH = 8
SEQ = 8192
DEPTH = 2
DEC_BATCH = 8
DEC_SEQ = 4096
PAST_LEN = 128

ATT_GROUPS = ((128, 1), (512, 4), (2048, 16))
ATT_HEADS = 8
ATT_HEAD_DIM = 64
ATT_GROUP_WIDTH = ATT_HEADS * ATT_HEAD_DIM
ATT_QKV_WIDTH = len(ATT_GROUPS) * 3 * ATT_GROUP_WIDTH
ROPE_DIM = ATT_HEAD_DIM // 4
ROPE_THETA = 500000.0
MLSTM_HEADS = 4
MLSTM_QK_DIM = D_MODEL // (2 * MLSTM_HEADS)
MLSTM_V_DIM = D_MODEL // MLSTM_HEADS
MLSTM_CHUNK = 128
MLSTM_IN_WIDTH = 2 * MLSTM_HEADS * MLSTM_QK_DIM + 2 * MLSTM_HEADS * MLSTM_V_DIM + 4 * MLSTM_HEADS
FFN_HIDDEN = int(math.ceil(8 * D_MODEL / 3 / 256)) * 256
N_MIXERS = 2
RMS_EPS = 1e-6

kernel_name = "hybrid_dilated_attn_mlstm_encoder"


def rms_norm(x, g):
    xf = x.astype(jnp.float32)
    y = xf * lax.rsqrt(jnp.mean(xf * xf, axis=-1, keepdims=True) + RMS_EPS)
    return (y * g.astype(jnp.float32)).astype(x.dtype)


def rope_partial(x, pos):
    half = ROPE_DIM // 2
    inv = jnp.float32(ROPE_THETA) ** (-jnp.arange(half, dtype=jnp.float32) / half)
    ang = pos.astype(jnp.float32)[:, None] * inv[None, :]
    cos = jnp.cos(ang)[None, :, None, :]
    sin = jnp.sin(ang)[None, :, None, :]
    xr = x[..., :ROPE_DIM].astype(jnp.float32)
    x1, x2 = xr[..., :half], xr[..., half:]
    rot = jnp.concatenate([x1 * cos - x2 * sin, x2 * cos + x1 * sin], axis=-1).astype(x.dtype)
    return jnp.concatenate([rot, x[..., ROPE_DIM:]], axis=-1)


def dilated_window_attention(q, k, v, window, dilation):
    B, S, H, Dh = q.shape
    r = window // (2 * dilation)
    L = S // dilation
    nb = -(-L // r)
    Lp = nb * r

    def phases(t):
        t = t.reshape(B, L, dilation, H, Dh).transpose(0, 2, 1, 3, 4)
        return jnp.pad(t, ((0, 0), (0, 0), (0, Lp - L), (0, 0), (0, 0)))

    qb = phases(q).reshape(B, dilation, nb, r, H, Dh)
    pad = ((0, 0), (0, 0), (r, r), (0, 0), (0, 0))
    kp = jnp.pad(phases(k), pad)
    vp = jnp.pad(phases(v), pad)
    kb = jnp.concatenate([kp[:, :, j * r:j * r + Lp].reshape(B, dilation, nb, r, H, Dh) for j in range(3)], axis=3)
    vb = jnp.concatenate([vp[:, :, j * r:j * r + Lp].reshape(B, dilation, nb, r, H, Dh) for j in range(3)], axis=3)

    blk = jnp.arange(nb)[:, None, None]
    qi = jnp.arange(r)[None, :, None]
    kt = jnp.arange(3 * r)[None, None, :]
    kpos = blk * r - r + kt
    rel = kt - r - qi
    mask = (jnp.abs(rel) <= r) & (kpos >= 0) & (kpos < L)

    s = jnp.einsum('bpnqhd,bpnkhd->bpnhqk', qb, kb).astype(jnp.float32) * (Dh ** -0.5)
    s = jnp.where(mask[None, None, :, None], s, -jnp.inf)
    m = jnp.max(s, axis=-1, keepdims=True)
    p = jnp.exp(s - m)
    den = jnp.sum(p, axis=-1)
    o = jnp.einsum('bpnhqk,bpnkhd->bpnqhd', p, vb.astype(jnp.float32))
    o = o / jnp.transpose(den, (0, 1, 2, 4, 3))[..., None]
    lse = m[..., 0] + jnp.log(den)
    o = o.reshape(B, dilation, Lp, H, Dh)[:, :, :L].transpose(0, 2, 1, 3, 4).reshape(B, S, H, Dh)
    lse = jnp.transpose(lse, (0, 1, 2, 4, 3)).reshape(B, dilation, Lp, H)[:, :, :L]
    lse = lse.transpose(0, 2, 1, 3).reshape(B, S, H)
    return o, lse


def dilated_attention_mixer(h, w_qkv, w_o):
    B, S, _ = h.shape
    proj = (h @ w_qkv).reshape(B, S, len(ATT_GROUPS), 3, ATT_HEADS, ATT_HEAD_DIM)
    pos = jnp.arange(S)
    outs, lses = [], []
    for g, (window, dil) in enumerate(ATT_GROUPS):
        q = rope_partial(proj[:, :, g, 0], pos)
        k = rope_partial(proj[:, :, g, 1], pos)
        v = proj[:, :, g, 2]
        o, lse = dilated_window_attention(q, k, v, window, dil)
        outs.append(o)
        lses.append(lse)
    wts = jax.nn.softmax(jnp.stack(lses, axis=0), axis=0)
    y = jnp.sum(wts[..., None] * jnp.stack(outs, axis=0), axis=0).astype(h.dtype)
    return y.reshape(B, S, ATT_GROUP_WIDTH) @ w_o


def mlstm_scan(q, k, v, i_pre, logf):
    B, S, H, dk = q.shape
    dv = v.shape[-1]
    L = MLSTM_CHUNK
    nc = S // L

    def vec_chunks(t):
        return t.reshape(B, nc, L, H, t.shape[-1]).transpose(1, 0, 3, 2, 4)

    def gate_chunks(t):
        return t.reshape(B, nc, L, H).transpose(1, 0, 3, 2)

    tril = jnp.tril(jnp.ones((L, L), dtype=bool))

    def body(carry, xs):
        C, n, m = carry
        qc, kc, vc, ic, fc = xs
        b = jnp.cumsum(fc, axis=-1)
        D = b[..., :, None] - b[..., None, :] + ic[..., None, :]
        D = jnp.where(tril, D, -jnp.inf)
        m_inter = b + m[..., None]
        m_t = jnp.maximum(m_inter, jnp.max(D, axis=-1))
        wts = jnp.exp(D - m_t[..., None])
        inter = jnp.exp(m_inter - m_t)
        sqk = jnp.einsum('bhtd,bhsd->bhts', qc, kc) * wts
        num = jnp.einsum('bhts,bhsv->bhtv', sqk, vc) + inter[..., None] * jnp.einsum('bhtd,bhdv->bhtv', qc, C)
        den = jnp.sum(sqk, axis=-1) + inter * jnp.einsum('bhtd,bhd->bht', qc, n)
        hc = num / jnp.maximum(jnp.abs(den), jnp.exp(-m_t))[..., None]
        g = b[..., -1:] - b + ic
        m_new = jnp.maximum(b[..., -1] + m, jnp.max(g, axis=-1))
        ws = jnp.exp(g - m_new[..., None])
        decay = jnp.exp(b[..., -1] + m - m_new)
        C_new = decay[..., None, None] * C + jnp.einsum('bhs,bhsd,bhsv->bhdv', ws, kc, vc)
        n_new = decay[..., None] * n + jnp.einsum('bhs,bhsd->bhd', ws, kc)
        return (C_new, n_new, m_new), hc

    init = (jnp.zeros((B, H, dk, dv), jnp.float32), jnp.zeros((B, H, dk), jnp.float32),
            jnp.zeros((B, H), jnp.float32))
    xs = (vec_chunks(q), vec_chunks(k), vec_chunks(v), gate_chunks(i_pre), gate_chunks(logf))
    _, hs = lax.scan(body, init, xs)
    return hs.transpose(1, 0, 3, 2, 4).reshape(B, S, H, dv)


def mlstm_mixer(h, w_in, b_gates, head_norm, w_out):
    B, S, _ = h.shape
    H, dk, dv = MLSTM_HEADS, MLSTM_QK_DIM, MLSTM_V_DIM
    proj = h @ w_in
    cuts = np.cumsum([H * dk, H * dk, H * dv, H * dv]).tolist()
    q, k, v, o, gates = jnp.split(proj, cuts, axis=-1)
    q = q.reshape(B, S, H, dk).astype(jnp.float32)
    k = k.reshape(B, S, H, dk).astype(jnp.float32) * (dk ** -0.5)
    v = v.reshape(B, S, H, dv).astype(jnp.float32)
    gates = (gates.astype(jnp.float32) + b_gates.astype(jnp.float32)).reshape(B, S, 4, H)
    i_fw, logf_fw = gates[:, :, 0], jax.nn.log_sigmoid(gates[:, :, 1])
    i_bw, logf_bw = gates[:, :, 2], jax.nn.log_sigmoid(gates[:, :, 3])
    flip = lambda t: jnp.flip(t, axis=1)
    h_fw = mlstm_scan(q, k, v, i_fw, logf_fw)
    h_bw = flip(mlstm_scan(flip(q), flip(k), flip(v), flip(i_bw), flip(logf_bw)))
    hs = h_fw + h_bw
    hs = hs * lax.rsqrt(jnp.mean(hs * hs, axis=-1, keepdims=True) + RMS_EPS)
    hs = hs * head_norm.astype(jnp.float32).reshape(H, dv)
    y = jax.nn.sigmoid(o) * hs.reshape(B, S, H * dv).astype(h.dtype)
    return y @ w_out


def swiglu(h, w_gu, w_down):
    a, b = jnp.split(h @ w_gu, 2, axis=-1)
    return (jax.nn.silu(a) * b) @ w_down


def run_trunk(x, c, layers, mixers, final_norm):
    for i in range(DEPTH):
        ada_w, ada_b, g1, g2, w_gu, w_down = layers[i]
        mixer = mixers[i % N_MIXERS]
        mod = (jax.nn.silu(c) @ ada_w + ada_b)[:, None, :]
        sh1, sc1, gt1, sh2, sc2, gt2 = jnp.split(mod, 6, axis=-1)
        hmix = rms_norm(x, g1) * (1 + sc1) + sh1
        x = x + gt1 * mixer(hmix)
        hffn = rms_norm(x, g2) * (1 + sc2) + sh2
        x = x + gt2 * swiglu(hffn, w_gu, w_down)
    return rms_norm(x, final_norm)


def setup_inputs(seed: int = 0) -> dict:
    key = jax.random.key(seed)
    ks = iter(jax.random.split(key, 40))
    nrm = lambda shape, s=1.0: s * jax.random.normal(next(ks), shape, jnp.float32)
    dense = lambda fi, fo, s=1.0: nrm((fi, fo), s * fi ** -0.5)
    gain = lambda n: 1.0 + nrm((n,), 0.02)
    H = MLSTM_HEADS
    b_gates = jnp.concatenate([nrm((H,), 0.1), 3.0 + nrm((H,), 0.5), nrm((H,), 0.1), 3.0 + nrm((H,), 0.5)])
    return {
        "x_prompt": nrm((BATCH, SEQ, D_MODEL)),
        "x_sample": nrm((DEC_BATCH, DEC_SEQ, D_MODEL)),
        "c_prompt": nrm((BATCH, D_MODEL)),
        "c_sample": nrm((DEC_BATCH, D_MODEL)),
        "l0_ada_w": dense(D_MODEL, 6 * D_MODEL, 0.5),
        "l0_ada_b": nrm((6 * D_MODEL,), 0.02),
        "l0_norm1": gain(D_MODEL),
        "l0_attn_w_qkv": dense(D_MODEL, ATT_QKV_WIDTH),
        "l0_attn_w_o": dense(ATT_GROUP_WIDTH, D_MODEL),
        "l0_norm2": gain(D_MODEL),
        "l0_ffn_w_gu": dense(D_MODEL, 2 * FFN_HIDDEN),
        "l0_ffn_w_down": dense(FFN_HIDDEN, D_MODEL),
        "l1_ada_w": dense(D_MODEL, 6 * D_MODEL, 0.5),
        "l1_ada_b": nrm((6 * D_MODEL,), 0.02),
        "l1_norm1": gain(D_MODEL),
        "l1_mlstm_w_in": dense(D_MODEL, MLSTM_IN_WIDTH),
        "l1_mlstm_b_gates": b_gates,
        "l1_mlstm_head_norm": gain(MLSTM_HEADS * MLSTM_V_DIM),
        "l1_mlstm_w_out": dense(MLSTM_HEADS * MLSTM_V_DIM, D_MODEL),
        "l1_norm2": gain(D_MODEL),
        "l1_ffn_w_gu": dense(D_MODEL, 2 * FFN_HIDDEN),
        "l1_ffn_w_down": dense(FFN_HIDDEN, D_MODEL),
        "final_norm": gain(D_MODEL),
    }


def reference(x_prompt, x_sample, c_prompt, c_sample,
              l0_ada_w, l0_ada_b, l0_norm1, l0_attn_w_qkv, l0_attn_w_o, l0_norm2, l0_ffn_w_gu, l0_ffn_w_down,
              l1_ada_w, l1_ada_b, l1_norm1, l1_mlstm_w_in, l1_mlstm_b_gates, l1_mlstm_head_norm, l1_mlstm_w_out,
              l1_norm2, l1_ffn_w_gu, l1_ffn_w_down, final_norm):
    mixers = [
        lambda h: dilated_attention_mixer(h, l0_attn_w_qkv, l0_attn_w_o),
        lambda h: mlstm_mixer(h, l1_mlstm_w_in, l1_mlstm_b_gates, l1_mlstm_head_norm, l1_mlstm_w_out),
    ]
    layers = [
        (l0_ada_w, l0_ada_b, l0_norm1, l0_norm2, l0_ffn_w_gu, l0_ffn_w_down),
        (l1_ada_w, l1_ada_b, l1_norm1, l1_norm2, l1_ffn_w_gu, l1_ffn_w_down),
    ]
    y_prompt = run_trunk(x_prompt, c_prompt, layers, mixers, final_norm)
    y_sample = run_trunk(x_sample, c_sample, layers, mixers, final_norm)
    return (y_prompt, y_sample)
```

```cpp
#include <hip/hip_runtime.h>
#include <hip/hip_cooperative_groups.h>
#include <cstdio>
#include <cstdint>
namespace cg = cooperative_groups;

#define LAS __attribute__((address_space(3)))
#define DI __device__ __forceinline__
typedef unsigned short bf16_t;
typedef short bf16x8 __attribute__((ext_vector_type(8)));
typedef short s16x4 __attribute__((ext_vector_type(4)));
typedef float f32x4 __attribute__((ext_vector_type(4)));
typedef float f32x2 __attribute__((ext_vector_type(2)));
typedef unsigned u32x4 __attribute__((ext_vector_type(4)));
typedef unsigned u32x2 __attribute__((ext_vector_type(2)));
typedef __bf16 bf16x2_t __attribute__((ext_vector_type(2)));
typedef short v4i16_t __attribute__((ext_vector_type(4)));

DI unsigned pk2(float lo, float hi) { f32x2 v = {lo, hi}; bf16x2_t b = __builtin_convertvector(v, bf16x2_t); return __builtin_bit_cast(unsigned, b); }
DI float bflo(unsigned u) { return __uint_as_float(u << 16); }
DI float bfhi(unsigned u) { return __uint_as_float(u & 0xffff0000u); }
DI float wave_sum(float v) {
#pragma unroll
    for (int o = 1; o < 64; o <<= 1) v += __shfl_xor(v, o);
    return v;
}
#define LBAR() do { asm volatile("s_waitcnt lgkmcnt(0)" ::: "memory"); __builtin_amdgcn_s_barrier(); asm volatile("" ::: "memory"); } while (0)

constexpr int D = 1024, TP = 65536, TSM = 32768, T = TP + TSM;
constexpr int NQKV = 4608, FFH = 2816, NGU = 5632, NIN = 3088, NINP = 3328, NPROJ = 3072;
constexpr float RMS_EPS = 1e-6f;
constexpr size_t MiB = 1u << 20;
constexpr size_t WS_MOD = 0;
constexpr size_t WS_BAR = 0xC4000;
constexpr size_t WS_ROWQ = 1 * MiB;
constexpr size_t WS_ZERO_BYTES = 4 * MiB;
constexpr size_t WS_ROPE = 4 * MiB;
constexpr size_t WS_WIN = 5 * MiB, WS_WOUT = 12 * MiB, WS_WGU1 = 14 * MiB, WS_WDN1 = 25 * MiB;
constexpr size_t WS_WQKV = 31 * MiB, WS_WO = 40 * MiB, WS_WGU0 = 41 * MiB, WS_WDN0 = 52 * MiB;
constexpr size_t WS_GATES = 31 * MiB;
constexpr size_t WS_R = 58 * MiB;
constexpr size_t WS_Y = 922 * MiB;
constexpr size_t WS_B = 250 * MiB;
constexpr size_t WS_HID1 = 442 * MiB;
constexpr size_t WS_HBW = 826 * MiB;
constexpr size_t WS_NEED = 1018 * MiB;
constexpr size_t OUT_LSE = 192 * MiB;
constexpr int LDS_BYTES = 147456;

DI int batch_of_row(int r) { return r < TP ? (r >> 13) : 8 + ((r - TP) >> 12); }
DI int pos_of_row(int r) { return r < TP ? (r & 8191) : ((r - TP) & 4095); }

namespace pg8 {
constexpr int BM = 256, BK = 64, HALF = 128, HTB = HALF * BK * 2, NXCD = 8, WGM = 8;
DI int lds_byte(int r, int c) { const int st = (r >> 4) * 2 + (c >> 5), rr = r & 15, cc = c & 31, ob = rr * 64 + cc * 2; return st * 1024 + (ob ^ (((ob >> 9) & 1) << 5)); }
DI void stage_rc(int b, int& R, int& C) { const int st = b / 1024, sb = b % 1024, swz = sb ^ (((sb >> 9) & 1) << 5); R = (st >> 1) * 16 + swz / 64; C = (st & 1) * 32 + (swz % 64) / 2; }
DI int perm32(int rho) { const int n = rho >> 4, i = rho & 15; return 8 * (i >> 2) + 4 * n + (i & 3); }
struct Unit { int pm, pn; };
struct Gemm { const bf16_t* A; const bf16_t* Bt; int lda, K, M, N; };
struct StaticOrder {
    int nM, nN, nwg, G, c;
    DI void init(int M, int N, int G_, int c_) { nM = M / BM; nN = N / BM; nwg = nM * nN; G = G_; c = c_; }
    DI bool next(int i, Unit& u) const {
        const long L = (long)i * G + c; if (L >= nwg) return false;
        int wgid = (int)L; { const int q = nwg / NXCD, r = nwg % NXCD, xcd = wgid % NXCD, off = wgid / NXCD; wgid = (xcd < r ? xcd * (q + 1) : r * (q + 1) + (xcd - r) * q) + off; }
        const int nig = WGM * nN, gid = wgid / nig, fm = gid * WGM, gsz = (nM - fm) < WGM ? (nM - fm) : WGM;
        u.pm = fm + ((wgid % nig) % gsz); u.pn = (wgid % nig) / gsz; return true;
    }
};

struct Epi {
    bf16_t* O;
    const float* rope;
    const float* base_p; const float* base_s; float* out; const float* gt;
    float* gates; const float* bg; const bf16_t* A3; const bf16_t* Wg;
    unsigned long long* rowq; const float* ng; const float* nsh; const float* nsc; bf16_t* hout; int fin;
};
DI float silu_f(float a) { return a * __builtin_amdgcn_rcpf(1.0f + __builtin_amdgcn_exp2f(-1.4426950408889634f * a)); }
template <int MODE> DI void epilogue(const Epi& E, f32x4 (&acc)[2][2][4][2], const Unit& u, int wr, int wc, int fr, int fq) {
    const int row0 = u.pm * BM + wr * 64 + fr;
    constexpr int emode = MODE;
    if constexpr (emode == 0) {
        const int colt = u.pn * BM; const int typ = (colt % 1536) >> 9;
        const bool rp = (typ < 2);
#pragma unroll
        for (int ai = 0; ai < 2; ++ai)
#pragma unroll
            for (int m = 0; m < 4; ++m) {
                const int row = row0 + ai * HALF + m * 16; const int pos = pos_of_row(row);
                f32x4 c0 = {1.f, 1.f, 1.f, 1.f}, c1 = c0, s0 = {0.f, 0.f, 0.f, 0.f}, s1 = s0;
                if (rp) { const f32x4* rt = (const f32x4*)(E.rope + (size_t)pos * 16); c0 = rt[0]; c1 = rt[1]; s0 = rt[2]; s1 = rt[3]; }
                const int pl0 = ((colt / 1536) * 3 + typ) * 8;
#pragma unroll
                for (int bj = 0; bj < 2; ++bj) {
                    const int hh_ = (((colt & 511) + wc * 64) >> 6);
                    bf16_t* rowp = E.O + ((size_t)(pl0 + hh_) * T + row) * 64 + bj * 32 + 8 * fq;
                    f32x4 v0 = acc[ai][bj][m][0], v1 = acc[ai][bj][m][1];
                    if (rp && bj == 0) {
                        f32x4 p0, p1;
#pragma unroll
                        for (int e = 0; e < 4; ++e) { p0[e] = __shfl_xor(v0[e], 16); p1[e] = __shfl_xor(v1[e], 16); }
                        if (fq == 0) { v0 = v0 * c0 - p0 * s0; v1 = v1 * c1 - p1 * s1; }
                        else if (fq == 1) { v0 = v0 * c0 + p0 * s0; v1 = v1 * c1 + p1 * s1; }
                    }
                    u32x4 w; w.x = pk2(v0[0], v0[1]); w.y = pk2(v0[2], v0[3]); w.z = pk2(v1[0], v1[1]); w.w = pk2(v1[2], v1[3]);
                    __builtin_nontemporal_store(w, (u32x4*)rowp);
                }
            }
    } else if constexpr (emode == 1) {
        const int bidx = batch_of_row(u.pm * BM);
        const char* base = (const char*)((u.pm * BM < TP) ? E.base_p : E.base_s);
        const int col0 = u.pn * BM + wc * 64 + 8 * fq;
        const unsigned ro = ((unsigned)row0 * D + (unsigned)col0) * 4u;
#define E1_OFF(ai, m, bj) (ro + (unsigned)(((ai) * HALF + (m) * 16) * D * 4 + (bj) * 32 * 4))
#pragma unroll
        for (int bj = 0; bj < 2; ++bj) {
            const f32x4 g0 = *(const f32x4*)(E.gt + bidx * 6144 + col0 + bj * 32), g1 = *(const f32x4*)(E.gt + bidx * 6144 + col0 + bj * 32 + 4);
#pragma unroll
            for (int ai = 0; ai < 2; ++ai)
#pragma unroll
                for (int m = 0; m < 4; ++m) {
                    const unsigned off = E1_OFF(ai, m, bj);
                    const f32x4 b0 = __builtin_nontemporal_load((const f32x4*)(base + off)), b1 = __builtin_nontemporal_load((const f32x4*)(base + off + 16));
                    acc[ai][bj][m][0] = b0 + g0 * acc[ai][bj][m][0];
                    acc[ai][bj][m][1] = b1 + g1 * acc[ai][bj][m][1];
                    asm volatile("" : "+v"(acc[ai][bj][m][0]), "+v"(acc[ai][bj][m][1]));
                }
            asm volatile("" ::: "memory");
        }
#pragma unroll
        for (int ai = 0; ai < 2; ++ai)
#pragma unroll
            for (int m = 0; m < 4; ++m) {
                float sq = 0.f;
#pragma unroll
                for (int bj = 0; bj < 2; ++bj)
#pragma unroll
                    for (int n = 0; n < 2; ++n) { const f32x4 v = acc[ai][bj][m][n]; sq += (v.x * v.x + v.y * v.y) + (v.z * v.z + v.w * v.w); }
                sq += __shfl_xor(sq, 16); sq += __shfl_xor(sq, 32);
                if (fq == 0) __hip_atomic_fetch_add(E.rowq + row0 + ai * HALF + m * 16, (1ull << 52) + (unsigned long long)(sq * 65536.0f + 0.5f), __ATOMIC_RELAXED, __HIP_MEMORY_SCOPE_AGENT);
            }
        if (!E.fin) {
            char* outp = (char*)E.out;
#pragma unroll
            for (int bj = 0; bj < 2; ++bj)
#pragma unroll
                for (int ai = 0; ai < 2; ++ai)
#pragma unroll
                    for (int m = 0; m < 4; ++m) {
                        const unsigned off = E1_OFF(ai, m, bj);
                        __builtin_nontemporal_store(acc[ai][bj][m][0], (f32x4*)(outp + off)); __builtin_nontemporal_store(acc[ai][bj][m][1], (f32x4*)(outp + off + 16));
                    }
        }
        float rs[2][4];
        { unsigned sp = 0;
          for (;;) {
              const unsigned long long ql = __hip_atomic_load(E.rowq + row0 + HALF + 48, __ATOMIC_RELAXED, __HIP_MEMORY_SCOPE_AGENT);
              if (__all((ql >> 52) >= 16ull)) {
                  bool done = true;
#pragma unroll
                  for (int ai = 0; ai < 2; ++ai)
#pragma unroll
                      for (int m = 0; m < 4; ++m) {
                          const unsigned long long q = __hip_atomic_load(E.rowq + row0 + ai * HALF + m * 16, __ATOMIC_RELAXED, __HIP_MEMORY_SCOPE_AGENT);
                          done = done && ((q >> 52) >= 16ull);
                          rs[ai][m] = rsqrtf((float)(q & ((1ull << 52) - 1ull)) * (1.0f / 65536.0f) * (1.0f / D) + RMS_EPS);
                      }
                  if (__all(done)) break;
              }
              __builtin_amdgcn_s_sleep(4);
              if (++sp > (1u << 18)) {
#pragma unroll
                  for (int ai = 0; ai < 2; ++ai)
#pragma unroll
                      for (int m = 0; m < 4; ++m) rs[ai][m] = 0.f;
                  break; }
          } }
#pragma unroll
        for (int bj = 0; bj < 2; ++bj) {
            const int c = col0 + bj * 32;
            f32x4 ga = *(const f32x4*)(E.ng + c), gb = *(const f32x4*)(E.ng + c + 4);
            f32x4 sha = {0.f, 0.f, 0.f, 0.f}, shb = sha;
            if (!E.fin) {
                const f32x4 sca = *(const f32x4*)(E.nsc + bidx * 6144 + c), scb = *(const f32x4*)(E.nsc + bidx * 6144 + c + 4);
                sha = *(const f32x4*)(E.nsh + bidx * 6144 + c); shb = *(const f32x4*)(E.nsh + bidx * 6144 + c + 4);
                ga = ga * (sca + 1.0f); gb = gb * (scb + 1.0f);
            }
#pragma unroll
            for (int ai = 0; ai < 2; ++ai)
#pragma unroll
                for (int m = 0; m < 4; ++m) {
                    const unsigned off = E1_OFF(ai, m, bj);
                    const f32x4 o0 = (acc[ai][bj][m][0] * rs[ai][m]) * ga + sha, o1 = (acc[ai][bj][m][1] * rs[ai][m]) * gb + shb;
                    if (E.fin) {
                        __builtin_nontemporal_store(o0, (f32x4*)((char*)E.out + off)); __builtin_nontemporal_store(o1, (f32x4*)((char*)E.out + off + 16));
                    } else {
                        u32x4 w; w.x = pk2(o0[0], o0[1]); w.y = pk2(o0[2], o0[3]); w.z = pk2(o1[0], o1[1]); w.w = pk2(o1[2], o1[3]);
                        *(u32x4*)((char*)E.hout + (off >> 1)) = w;
                    }
                }
        }
#undef E1_OFF
    } else if constexpr (emode == 2) {
        const int colh = u.pn * HALF + wc * 32 + 8 * fq;
#pragma unroll
        for (int ai = 0; ai < 2; ++ai)
#pragma unroll
            for (int m = 0; m < 4; ++m) {
                bf16_t* rowp = E.O + (size_t)(row0 + ai * HALF + m * 16) * FFH + colh;
                const f32x4 a0 = acc[ai][0][m][0], a1 = acc[ai][0][m][1], b0 = acc[ai][1][m][0], b1 = acc[ai][1][m][1];
                u32x4 w;
                w.x = pk2(silu_f(a0[0]) * b0[0], silu_f(a0[1]) * b0[1]); w.y = pk2(silu_f(a0[2]) * b0[2], silu_f(a0[3]) * b0[3]);
                w.z = pk2(silu_f(a1[0]) * b1[0], silu_f(a1[1]) * b1[1]); w.w = pk2(silu_f(a1[2]) * b1[2], silu_f(a1[3]) * b1[3]);
                __builtin_nontemporal_store(w, (u32x4*)rowp);
            }
    } else {
        if (u.pn < 12) {
            const int colt = u.pn * BM; const float sc = (colt >= 512 && colt < 1024) ? 0.08838834764831845f : 1.0f;
#pragma unroll
            for (int ai = 0; ai < 2; ++ai)
#pragma unroll
                for (int m = 0; m < 4; ++m) {
                    bf16_t* rowp = E.O + (size_t)(row0 + ai * HALF + m * 16) * NPROJ + colt + wc * 64 + 8 * fq;
#pragma unroll
                    for (int bj = 0; bj < 2; ++bj) {
                        const f32x4 v0 = acc[ai][bj][m][0] * sc, v1 = acc[ai][bj][m][1] * sc;
                        u32x4 w; w.x = pk2(v0[0], v0[1]); w.y = pk2(v0[2], v0[3]); w.z = pk2(v1[0], v1[1]); w.w = pk2(v1[2], v1[3]);
                        *(u32x4*)(rowp + bj * 32) = w;
                    }
                }
        }
        if (u.pn == ((((u.pm >> 3) % 6)) & 3)) {
            const int r0 = u.pm * BM + (wr * 4 + wc) * 32;
            const bf16_t* Ap = E.A3 + (size_t)(r0 + fr) * D + fq * 8;
            const bf16_t* Bp = E.Wg + (size_t)fr * D + fq * 8;
            f32x4 g0 = {0.f, 0.f, 0.f, 0.f}, g1 = g0;
            for (int k0 = 0; k0 < 32; k0 += 8) {
                bf16x8 a0[8], a1[8], bq[8];
#pragma unroll
                for (int q = 0; q < 8; ++q) { a0[q] = *(const bf16x8*)(Ap + (k0 + q) * 32); a1[q] = *(const bf16x8*)(Ap + 16 * D + (k0 + q) * 32); bq[q] = *(const bf16x8*)(Bp + (k0 + q) * 32); }
#pragma unroll
                for (int q = 0; q < 8; ++q) { g0 = __builtin_amdgcn_mfma_f32_16x16x32_bf16(a0[q], bq[q], g0, 0, 0, 0); g1 = __builtin_amdgcn_mfma_f32_16x16x32_bf16(a1[q], bq[q], g1, 0, 0, 0); }
            }
            const float bgv = E.bg[fr];
#pragma unroll
            for (int i = 0; i < 4; ++i) {
                E.gates[(size_t)(r0 + 4 * fq + i) * 16 + fr] = g0[i] + bgv;
                E.gates[(size_t)(r0 + 16 + 4 * fq + i) * 16 + fr] = g1[i] + bgv;
            }
        }
    }
}

template <int MODE> DI void gemm_phase(LAS unsigned char* lds, const Gemm g, const StaticOrder& S, const Epi& E) {
    int tid_ = threadIdx.x; asm volatile("" : "+v"(tid_)); const int tid = tid_, wid = __builtin_amdgcn_readfirstlane(tid >> 6), lane = tid & 63, wr = wid >> 2, wc = wid & 3, fr = lane & 15, fq = lane >> 4;
    const int K = g.K, nt = K / BK, lda = g.lda;
    unsigned voffA[2], voffB[2];
#pragma unroll
    for (int i = 0; i < 2; ++i) { int R, C; stage_rc(tid * 16 + i * 8192, R, C);
        voffA[i] = (unsigned)(R * lda + C) * 2u; voffB[i] = (unsigned)((((R >> 5) * 64 + perm32(R & 31)) * K) + C) * 2u; }
    const size_t kstep = (size_t)(BK * 2);
    const size_t hstepA = (size_t)HALF * lda * 2, tstepA = 2 * hstepA;
    const size_t hstepB = (size_t)32 * K * 2, tstepB = (size_t)BM * K * 2;
    const unsigned ldsw = (unsigned)wid * 1024u;
    const int aoff = lds_byte(wr * 64 + fr, fq * 8), boff = lds_byte(wc * 32 + fr, fq * 8);
#define PG8_SA(b, h) (((b) * 2 + (h)) * HTB)
#define PG8_SB(b, h) ((4 + (b) * 2 + (h)) * HTB)
#define PG8_STAGE(bufoff, gbase, voff) do { _Pragma("unroll") for (int _i = 0; _i < 2; ++_i) \
        __builtin_amdgcn_global_load_lds((const unsigned*)((const char*)(gbase) + (voff)[_i]), (LAS unsigned*)(lds + (bufoff) + ldsw + _i * 8192), 16, 0, 0); } while (0)
#define PG8_LDA(dst, b, h) do { _Pragma("unroll") for (int m = 0; m < 4; ++m) _Pragma("unroll") for (int k = 0; k < 2; ++k) dst[m][k] = *(const LAS bf16x8*)(lds + PG8_SA(b, h) + aoff + m * 2048 + k * 1024); } while (0)
#define PG8_LDB(dst, b, h) do { _Pragma("unroll") for (int n = 0; n < 2; ++n) _Pragma("unroll") for (int k = 0; k < 2; ++k) dst[n][k] = *(const LAS bf16x8*)(lds + PG8_SB(b, h) + boff + n * 2048 + k * 1024); } while (0)
#define PG8_MMA(ai, bj, At, Bt) do { __builtin_amdgcn_s_setprio(1); _Pragma("unroll") for (int m = 0; m < 4; ++m) _Pragma("unroll") for (int n = 0; n < 2; ++n) _Pragma("unroll") for (int k = 0; k < 2; ++k) \
        acc[ai][bj][m][n] = __builtin_amdgcn_mfma_f32_16x16x32_bf16(Bt[n][k], At[m][k], acc[ai][bj][m][n], 0, 0, 0); __builtin_amdgcn_s_setprio(0); } while (0)
#define PG8_WAIT_V(n) asm volatile("s_waitcnt vmcnt(" #n ")" ::: "memory")
#define PG8_WAIT_L(n) asm volatile("s_waitcnt lgkmcnt(" #n ")" ::: "memory")
#define PG8_BAR __builtin_amdgcn_s_barrier()
#define PG8_SCHED __builtin_amdgcn_sched_barrier(0)
    Unit cur, nxt; int ui = 0;
    if (!S.next(0, cur)) return;
    f32x4 acc[2][2][4][2];
#pragma unroll
    for (int a = 0; a < 2; ++a)
#pragma unroll
        for (int b = 0; b < 2; ++b)
#pragma unroll
            for (int m = 0; m < 4; ++m)
#pragma unroll
                for (int n = 0; n < 2; ++n) acc[a][b][m][n] = (f32x4){0.f, 0.f, 0.f, 0.f};
    bf16x8 At[4][2], B0[2][2], B1[2][2];
    const char* cA = (const char*)g.A + (size_t)cur.pm * tstepA; const char* cB = (const char*)g.Bt + (size_t)cur.pn * tstepB;
    PG8_STAGE(PG8_SB(0, 0), cB, voffB); PG8_STAGE(PG8_SB(0, 1), cB + hstepB, voffB); PG8_STAGE(PG8_SA(0, 0), cA, voffA); PG8_STAGE(PG8_SA(0, 1), cA + hstepA, voffA);
    if (wr == 1) PG8_BAR;
    PG8_WAIT_V(2); PG8_BAR;
    PG8_STAGE(PG8_SB(1, 0), cB + kstep, voffB); PG8_STAGE(PG8_SA(1, 0), cA + kstep, voffA); PG8_STAGE(PG8_SB(1, 1), cB + hstepB + kstep, voffB);
    PG8_WAIT_V(6); PG8_BAR;
    for (;;) {
        const bool has_next = S.next(ui + 1, nxt);
        const char* nA = has_next ? (const char*)g.A + (size_t)nxt.pm * tstepA : cA; const char* nB = has_next ? (const char*)g.Bt + (size_t)nxt.pn * tstepB : cB;
        for (int t = 0; t < nt; t += 2) {
            const bool last = (t == nt - 2);
            const char* a1 = cA + (size_t)(t + 1) * kstep;
            const char* a2 = last ? nA : cA + (size_t)(t + 2) * kstep; const char* b2 = last ? nB : cB + (size_t)(t + 2) * kstep;
            const char* a3 = a2 + kstep; const char* b3 = b2 + kstep;
            PG8_LDB(B0, 0, 0); PG8_LDB(B1, 0, 1); PG8_SCHED; PG8_LDA(At, 0, 0); PG8_STAGE(PG8_SA(1, 1), a1 + hstepA, voffA);
            PG8_WAIT_V(8); PG8_WAIT_L(0); PG8_BAR; PG8_MMA(0, 0, At, B0); PG8_MMA(0, 1, At, B1); PG8_BAR; PG8_SCHED;
            PG8_LDA(At, 0, 1); PG8_STAGE(PG8_SB(0, 0), b2, voffB); PG8_STAGE(PG8_SB(0, 1), b2 + hstepB, voffB); PG8_STAGE(PG8_SA(0, 0), a2, voffA);
            PG8_WAIT_V(8); PG8_WAIT_L(0); PG8_BAR; PG8_MMA(1, 0, At, B0); PG8_MMA(1, 1, At, B1); PG8_BAR; PG8_SCHED;
            PG8_LDB(B0, 1, 0); PG8_LDB(B1, 1, 1); PG8_SCHED; PG8_LDA(At, 1, 0); PG8_STAGE(PG8_SA(0, 1), a2 + hstepA, voffA);
            PG8_WAIT_V(8); PG8_WAIT_L(0); PG8_BAR; PG8_MMA(0, 0, At, B0); PG8_MMA(0, 1, At, B1); PG8_BAR; PG8_SCHED;
            PG8_LDA(At, 1, 1); PG8_STAGE(PG8_SB(1, 0), b3, voffB); PG8_STAGE(PG8_SB(1, 1), b3 + hstepB, voffB); PG8_STAGE(PG8_SA(1, 0), a3, voffA);
            PG8_WAIT_V(8); PG8_WAIT_L(0); PG8_BAR; PG8_MMA(1, 0, At, B0); PG8_MMA(1, 1, At, B1); PG8_BAR; PG8_SCHED;
        }
        if (wr == 0) PG8_BAR;
        epilogue<MODE>(E, acc, cur, wr, wc, fr, fq);
        if (!has_next) break;
#pragma unroll
        for (int a = 0; a < 2; ++a)
#pragma unroll
            for (int b = 0; b < 2; ++b)
#pragma unroll
                for (int m = 0; m < 4; ++m)
#pragma unroll
                    for (int n = 0; n < 2; ++n) acc[a][b][m][n] = (f32x4){0.f, 0.f, 0.f, 0.f};
        cur = nxt; cA = nA; cB = nB; ++ui;
        if (wr == 1) PG8_BAR;
    }
    PG8_WAIT_V(0);
    PG8_BAR;
#undef PG8_SA
#undef PG8_SB
#undef PG8_STAGE
#undef PG8_LDA
#undef PG8_LDB
#undef PG8_MMA
#undef PG8_WAIT_V
#undef PG8_WAIT_L
#undef PG8_BAR
#undef PG8_SCHED
}
}

DI void transpose_item(const float* W, int K, int N, int ncols, bf16_t* WT, int gu, LAS float* scr, int item, int lane) {
    const int nblk = ncols / 32, kb = item / nblk, nb = item % nblk, k0 = 64 * kb, n0 = 32 * nb;
#pragma unroll 8
    for (int i = 0; i < 32; ++i) { const int kk = 2 * i + (lane >> 5); scr[kk * 33 + (lane & 31)] = W[(size_t)(k0 + kk) * N + n0 + (lane & 31)]; }
    asm volatile("s_waitcnt lgkmcnt(0)" ::: "memory");
    int r0 = n0;
    if (gu) { const int nn = (n0 < FFH) ? n0 : n0 - FFH; r0 = 256 * (nn >> 7) + 64 * ((nn & 127) >> 5) + ((n0 < FFH) ? 0 : 32); }
    const int c = lane & 7;
#pragma unroll
    for (int j = 0; j < 4; ++j) { const int n = (lane >> 3) + 8 * j; const LAS float* s = scr + (8 * c) * 33 + n;
        u32x4 o; o.x = pk2(s[0 * 33], s[1 * 33]); o.y = pk2(s[2 * 33], s[3 * 33]); o.z = pk2(s[4 * 33], s[5 * 33]); o.w = pk2(s[6 * 33], s[7 * 33]);
        *(u32x4*)(WT + (size_t)(r0 + n) * K + k0 + 8 * c) = o; }
    asm volatile("s_waitcnt lgkmcnt(0)" ::: "memory");
}

DI void sincos_d(double x, float& s, float& c) {
    const double q = __builtin_rint(x * 0.63661977236758134308);
    const double r = (x - q * 1.57079632679489655800) - q * 6.12323399573676603587e-17;
    const double r2 = r * r;
    double sp = 1.0 / 6227020800.0; sp = sp * r2 - 1.0 / 39916800.0; sp = sp * r2 + 1.0 / 362880.0; sp = sp * r2 - 1.0 / 5040.0; sp = sp * r2 + 1.0 / 120.0; sp = sp * r2 - 1.0 / 6.0; sp = sp * r2 + 1.0; sp *= r;
    double cp = -1.0 / 87178291200.0; cp = cp * r2 + 1.0 / 479001600.0; cp = cp * r2 - 1.0 / 3628800.0; cp = cp * r2 + 1.0 / 40320.0; cp = cp * r2 - 1.0 / 720.0; cp = cp * r2 + 1.0 / 24.0; cp = cp * r2 - 0.5; cp = cp * r2 + 1.0;
    const int qi = ((int)q) & 3;
    const double ss = (qi == 0) ? sp : (qi == 1) ? cp : (qi == 2) ? -sp : -cp;
    const double cc = (qi == 0) ? cp : (qi == 1) ? -sp : (qi == 2) ? -cp : sp;
    s = (float)ss; c = (float)cc;
}

struct Args { const float* in[23]; float* out; unsigned char* ws; };

DI void prologue(LAS unsigned char* lds, const Args& a, int G, int bid) {
    int tid_ = threadIdx.x; asm volatile("" : "+v"(tid_)); asm volatile("" : "+s"(bid)); const int tid = tid_, wid = __builtin_amdgcn_readfirstlane(tid >> 6), lane = tid & 63;
    LAS float* scr = (LAS float*)(lds + wid * 16384);
    unsigned char* ws = a.ws;
    const int gw = bid * 8 + wid, NGW = G * 8;
    constexpr int I_QKV = 16 * (NQKV / 32), I_WO = 8 * (D / 32), I_GU = 16 * (NGU / 32), I_DN = (FFH / 64) * (D / 32), I_IN = 16 * (NPROJ / 32), I_OUT = 16 * (D / 32);
    constexpr int NITEMS = I_QKV + I_WO + 2 * I_GU + 2 * I_DN + I_IN + I_OUT;
    for (int it = gw; it < NITEMS; it += NGW) {
        int r = it;
        if (r < I_QKV) { transpose_item(a.in[7], D, NQKV, NQKV, (bf16_t*)(ws + WS_WQKV), 0, scr, r, lane); continue; } r -= I_QKV;
        if (r < I_WO) { transpose_item(a.in[8], 512, D, D, (bf16_t*)(ws + WS_WO), 0, scr, r, lane); continue; } r -= I_WO;
        if (r < I_GU) { transpose_item(a.in[10], D, NGU, NGU, (bf16_t*)(ws + WS_WGU0), 1, scr, r, lane); continue; } r -= I_GU;
        if (r < I_DN) { transpose_item(a.in[11], FFH, D, D, (bf16_t*)(ws + WS_WDN0), 0, scr, r, lane); continue; } r -= I_DN;
        if (r < I_IN) { transpose_item(a.in[15], D, NIN, NPROJ, (bf16_t*)(ws + WS_WIN), 0, scr, r, lane); continue; } r -= I_IN;
        if (r < I_OUT) { transpose_item(a.in[18], D, D, D, (bf16_t*)(ws + WS_WOUT), 0, scr, r, lane); continue; } r -= I_OUT;
        if (r < I_GU) { transpose_item(a.in[20], D, NGU, NGU, (bf16_t*)(ws + WS_WGU1), 1, scr, r, lane); continue; } r -= I_GU;
        transpose_item(a.in[21], FFH, D, D, (bf16_t*)(ws + WS_WDN1), 0, scr, r, lane);
    }
    {
        bf16_t* wt = (bf16_t*)(ws + WS_WIN); const float* W = a.in[15];
        for (int e = bid * 512 + tid; e < 256 * D; e += G * 512) {
            const int rr = e >> 10, k = e & 1023; const int n = NPROJ + rr;
            float v = 0.f; if (n < NIN) v = W[(size_t)k * NIN + n];
            wt[(size_t)n * D + k] = (bf16_t)(pk2(v, 0.f) & 0xffffu);
        }
    }
    {
        float* rope = (float*)(ws + WS_ROPE);
        for (int e = bid * 512 + tid; e < 8192 * 8; e += G * 512) {
            const int pos = e >> 3, i = e & 7;
            const float inv = exp2f(-(float)i * 0.125f * 18.931568569324174f);
            const float ang = (float)pos * inv;
            float s, c; sincos_d((double)ang, s, c);
            rope[pos * 16 + i] = c; rope[pos * 16 + 8 + i] = s;
        }
    }
    {
        float* mod = (float*)(ws + WS_MOD);
        for (int it = gw; it < 2 * 96 * 16; it += NGW) {
            const int ks = it & 15, cb = (it >> 4) % 96, layer = it / (96 * 16);
            const float* W = a.in[layer ? 12 : 4]; const float* bias = a.in[layer ? 13 : 5];
            const int n = cb * 64 + lane, k0 = ks * 64;
#pragma unroll
            for (int b = 0; b < 16; ++b) {
                const float cv = (b < 8) ? a.in[2][b * D + k0 + lane] : a.in[3][(b - 8) * D + k0 + lane];
                scr[b * 64 + lane] = cv / (1.0f + __expf(-cv));
            }
            asm volatile("s_waitcnt lgkmcnt(0)" ::: "memory");
            float accm[16];
#pragma unroll
            for (int b = 0; b < 16; ++b) accm[b] = 0.f;
            for (int kk = 0; kk < 64; ++kk) {
                const float w = W[(size_t)(k0 + kk) * 6144 + n];
#pragma unroll
                for (int b = 0; b < 16; ++b) accm[b] += scr[b * 64 + kk] * w;
            }
            const float bv = (ks == 0) ? bias[n] : 0.f;
#pragma unroll
            for (int b = 0; b < 16; ++b) atomicAdd(mod + ((size_t)layer * 16 + b) * 6144 + n, accm[b] + bv);
            asm volatile("s_waitcnt lgkmcnt(0)" ::: "memory");
        }
    }
}

DI void normmod_phase(const float* xp, const float* xs, const float* g, const float* sh, const float* sc, bf16_t* out, int G, int bid) {
    int tid_ = threadIdx.x; asm volatile("" : "+v"(tid_)); asm volatile("" : "+s"(bid)); const int tid = tid_, wid = tid >> 6, lane = tid & 63;
    const int gw = bid * 8 + wid, NGW = G * 8;
    f32x4 v[4], u[4];
    int row = gw;
    if (row < T) { const float* src = (row < TP ? xp : xs) + (size_t)row * D;
#pragma unroll
        for (int j = 0; j < 4; ++j) v[j] = __builtin_nontemporal_load(((const f32x4*)src) + 64 * j + lane); }
    while (row < T) {
        const int nrow = row + NGW;
        if (nrow < T) { const float* src = (nrow < TP ? xp : xs) + (size_t)nrow * D;
#pragma unroll
            for (int j = 0; j < 4; ++j) u[j] = __builtin_nontemporal_load(((const f32x4*)src) + 64 * j + lane); }
        float ss = 0.f;
#pragma unroll
        for (int j = 0; j < 4; ++j) ss += (v[j].x * v[j].x + v[j].y * v[j].y) + (v[j].z * v[j].z + v[j].w * v[j].w);
        const float rstd = rsqrtf(wave_sum(ss) * (1.0f / D) + RMS_EPS);
        const int bidx = batch_of_row(row);
#pragma unroll
        for (int j = 0; j < 4; ++j) {
            const int c = 256 * j + 4 * lane;
            const f32x4 g4 = *(const f32x4*)(g + c), sc4 = *(const f32x4*)(sc + bidx * 6144 + c), sh4 = *(const f32x4*)(sh + bidx * 6144 + c);
            const f32x4 o = (v[j] * rstd) * g4 * (sc4 + 1.0f) + sh4;
            u32x2 w; w.x = pk2(o.x, o.y); w.y = pk2(o.z, o.w);
            *(u32x2*)(out + (size_t)row * D + c) = w;
        }
#pragma unroll
        for (int j = 0; j < 4; ++j) v[j] = u[j];
        row = nrow;
    }
}
DI void finalnorm_phase(float* x, const float* g, int G, int bid) {
    int tid_ = threadIdx.x; asm volatile("" : "+v"(tid_)); asm volatile("" : "+s"(bid)); const int tid = tid_, wid = tid >> 6, lane = tid & 63;
    const int gw = bid * 8 + wid, NGW = G * 8;
    for (int row = gw; row < T; row += NGW) {
        float* src = x + (size_t)row * D;
        f32x4 v[4]; float ss = 0.f;
#pragma unroll
        for (int j = 0; j < 4; ++j) { v[j] = ((const f32x4*)src)[64 * j + lane]; ss += (v[j].x * v[j].x + v[j].y * v[j].y) + (v[j].z * v[j].z + v[j].w * v[j].w); }
        const float rstd = rsqrtf(wave_sum(ss) * (1.0f / D) + RMS_EPS);
#pragma unroll
        for (int j = 0; j < 4; ++j) { const f32x4 g4 = *(const f32x4*)(g + 256 * j + 4 * lane); ((f32x4*)src)[64 * j + lane] = (v[j] * rstd) * g4; }
    }
}

constexpr int AK_STRIDE = 144, AV_STRIDE = 160, AK_BYTES = 384 * AK_STRIDE;
struct AttnUnit { int tok0, dsh, p, l0, L, g, h; };
DI AttnUnit attn_decode(int u) {
    AttnUnit a; a.h = u & 7; a.g = (u >> 3) % 3; const int tt = u / 24;
    int sg, S;
    if (tt < 256) { a.tok0 = (tt >> 5) * 8192; sg = tt & 31; S = 8192; } else { const int t2 = tt - 256; a.tok0 = TP + (t2 >> 4) * 4096; sg = t2 & 15; S = 4096; }
    a.dsh = 2 * a.g; a.L = S >> a.dsh; const int spp = a.L >> 8; a.p = sg / spp; a.l0 = (sg % spp) * 256;
    return a;
}
DI void attn_phase(LAS unsigned char* lds, bf16_t* QKV, float* lse, int G, int bid) {
    int tid_ = threadIdx.x; asm volatile("" : "+v"(tid_)); asm volatile("" : "+s"(bid)); const int tid = tid_, wid = __builtin_amdgcn_readfirstlane(tid >> 6), lane = tid & 63, fr = lane & 15, fq = lane >> 4;
    LAS unsigned char* Ks = lds; LAS unsigned char* Vs = lds + AK_BYTES;
    const int NU = (T / 256) * 24;
    const int bi = wid >> 1, half = wid & 1;
    u32x4 pk_[6], pv_[6]; bf16x8 pq_[2][2];
    if (bid < NU) {
        const AttnUnit a = attn_decode(bid);
        const bf16_t* qb = QKV + (size_t)((a.g * 3) * 8 + a.h) * T * 64; const bf16_t* kb = qb + (size_t)8 * T * 64; const bf16_t* vb = kb + (size_t)8 * T * 64;
#pragma unroll
        for (int ps = 0; ps < 6; ++ps) { const int rr = ps * 64 + (tid >> 3), ch = tid & 7, l = a.l0 - 64 + rr;
            u32x4 kv = {0u, 0u, 0u, 0u}, vv = kv;
            if (l >= 0 && l < a.L) { const size_t tok = (size_t)a.tok0 + ((size_t)l << a.dsh) + a.p; kv = *(const u32x4*)(kb + tok * 64 + ch * 8); vv = *(const u32x4*)(vb + tok * 64 + ch * 8); }
            pk_[ps] = kv; pv_[ps] = vv; }
#pragma unroll
        for (int qt = 0; qt < 2; ++qt) { const int l = a.l0 + 64 * bi + 32 * half + 16 * qt + fr; const size_t tok = (size_t)a.tok0 + ((size_t)l << a.dsh) + a.p;
#pragma unroll
            for (int ks = 0; ks < 2; ++ks) pq_[qt][ks] = *(const bf16x8*)(qb + tok * 64 + ks * 32 + fq * 8); }
    }
    for (int u = bid; u < NU; u += G) {
        const AttnUnit a = attn_decode(u);
        LBAR();
#pragma unroll
        for (int ps = 0; ps < 6; ++ps) { const int rr = ps * 64 + (tid >> 3), ch = tid & 7;
            *(LAS u32x4*)(Ks + rr * AK_STRIDE + ch * 16) = pk_[ps]; *(LAS u32x4*)(Vs + rr * AV_STRIDE + ch * 16) = pv_[ps]; }
        bf16x8 qf[2][2];
#pragma unroll
        for (int qt = 0; qt < 2; ++qt)
#pragma unroll
            for (int ks = 0; ks < 2; ++ks) qf[qt][ks] = pq_[qt][ks];
        if (u + G < NU) {
            const AttnUnit b = attn_decode(u + G);
            const bf16_t* qb = QKV + (size_t)((b.g * 3) * 8 + b.h) * T * 64; const bf16_t* kb = qb + (size_t)8 * T * 64; const bf16_t* vb = kb + (size_t)8 * T * 64;
#pragma unroll
            for (int ps = 0; ps < 6; ++ps) { const int rr = ps * 64 + (tid >> 3), ch = tid & 7, l = b.l0 - 64 + rr;
                u32x4 kv = {0u, 0u, 0u, 0u}, vv = kv;
                if (l >= 0 && l < b.L) { const size_t tok = (size_t)b.tok0 + ((size_t)l << b.dsh) + b.p; kv = *(const u32x4*)(kb + tok * 64 + ch * 8); vv = *(const u32x4*)(vb + tok * 64 + ch * 8); }
                pk_[ps] = kv; pv_[ps] = vv; }
#pragma unroll
            for (int qt = 0; qt < 2; ++qt) { const int l = b.l0 + 64 * bi + 32 * half + 16 * qt + fr; const size_t tok = (size_t)b.tok0 + ((size_t)l << b.dsh) + b.p;
#pragma unroll
                for (int ks = 0; ks < 2; ++ks) pq_[qt][ks] = *(const bf16x8*)(qb + tok * 64 + ks * 32 + fq * 8); }
        }
        LBAR();
        f32x4 sacc[10][2];
#pragma unroll
        for (int jt = 0; jt < 10; ++jt) { sacc[jt][0] = (f32x4){0.f, 0.f, 0.f, 0.f}; sacc[jt][1] = sacc[jt][0]; }
        const int krow0 = 64 * bi + 32 * half;
#pragma unroll
        for (int jb = 0; jb < 5; ++jb) {
            bf16x8 kf[2][2];
#pragma unroll
            for (int j5 = 0; j5 < 2; ++j5)
#pragma unroll
                for (int ks = 0; ks < 2; ++ks) kf[j5][ks] = *(const LAS bf16x8*)(Ks + (krow0 + 16 * (2 * jb + j5) + fr) * AK_STRIDE + ks * 64 + fq * 16);
            __builtin_amdgcn_sched_barrier(0);
#pragma unroll
            for (int ks = 0; ks < 2; ++ks)
#pragma unroll
                for (int j5 = 0; j5 < 2; ++j5) {
                    if (2 * jb + j5 <= 8) sacc[2 * jb + j5][0] = __builtin_amdgcn_mfma_f32_16x16x32_bf16(kf[j5][ks], qf[0][ks], sacc[2 * jb + j5][0], 0, 0, 0);
                    if (2 * jb + j5 >= 1) sacc[2 * jb + j5][1] = __builtin_amdgcn_mfma_f32_16x16x32_bf16(kf[j5][ks], qf[1][ks], sacc[2 * jb + j5][1], 0, 0, 0);
                }
            __builtin_amdgcn_sched_barrier(0);
        }
        const float SC = 0.125f * 1.4426950408889634f;
        float mx[2], den[2];
        const int lkb = a.l0 + 64 * bi - 64 + 32 * half;
        const bool edge = (lkb < 0) || (lkb + 160 > a.L);
#pragma unroll
        for (int qt = 0; qt < 2; ++qt) {
            float m = -1e30f;
#pragma unroll
            for (int jt = 0; jt < 10; ++jt) {
                const int dj = jt - qt;
                if (dj < 0 || dj > 8) continue;
#pragma unroll
                for (int i = 0; i < 4; ++i) {
                    float sv = sacc[jt][qt][i];
                    if (dj == 0) sv = (4 * fq + i >= fr) ? sv : -1e30f;
                    if (dj == 8) sv = (4 * fq + i <= fr) ? sv : -1e30f;
                    if (edge) { const int lk = lkb + 16 * jt + 4 * fq + i; sv = (lk >= 0 && lk < a.L) ? sv : -1e30f; }
                    sacc[jt][qt][i] = sv; m = fmaxf(m, sv);
                }
            }
            m = fmaxf(m, __shfl_xor(m, 16)); m = fmaxf(m, __shfl_xor(m, 32));
            m *= SC;
            float d = 0.f;
#pragma unroll
            for (int jt = 0; jt < 10; ++jt) {
                const int dj = jt - qt;
                if (dj < 0 || dj > 8) { sacc[jt][qt] = (f32x4){0.f, 0.f, 0.f, 0.f}; continue; }
#pragma unroll
                for (int i = 0; i < 4; ++i) { const float p = __builtin_amdgcn_exp2f(__builtin_fmaf(sacc[jt][qt][i], SC, -m)); sacc[jt][qt][i] = p; d += p; }
            }
            d += __shfl_xor(d, 16); d += __shfl_xor(d, 32);
            mx[qt] = m; den[qt] = d;
        }
        f32x4 oacc[4][2];
#pragma unroll
        for (int dt = 0; dt < 4; ++dt) { oacc[dt][0] = (f32x4){0.f, 0.f, 0.f, 0.f}; oacc[dt][1] = oacc[dt][0]; }
#pragma unroll
        for (int jj = 0; jj < 5; ++jj) {
            bf16x8 pb[2];
#pragma unroll
            for (int qt = 0; qt < 2; ++qt) {
                u32x4 w; w.x = pk2(sacc[2 * jj][qt][0], sacc[2 * jj][qt][1]); w.y = pk2(sacc[2 * jj][qt][2], sacc[2 * jj][qt][3]);
                w.z = pk2(sacc[2 * jj + 1][qt][0], sacc[2 * jj + 1][qt][1]); w.w = pk2(sacc[2 * jj + 1][qt][2], sacc[2 * jj + 1][qt][3]);
                pb[qt] = __builtin_bit_cast(bf16x8, w);
            }
            const int vr = krow0 + 32 * jj + 4 * fq + (fr >> 2);
            bf16x8 vf[4];
#pragma unroll
            for (int dt = 0; dt < 4; ++dt) {
                const s16x4 lo = __builtin_bit_cast(s16x4, __builtin_amdgcn_ds_read_tr16_b64_v4i16((LAS v4i16_t*)(Vs + vr * AV_STRIDE + (16 * dt + 4 * (fr & 3)) * 2)));
                const s16x4 hi = __builtin_bit_cast(s16x4, __builtin_amdgcn_ds_read_tr16_b64_v4i16((LAS v4i16_t*)(Vs + (vr + 16) * AV_STRIDE + (16 * dt + 4 * (fr & 3)) * 2)));
                vf[dt] = (bf16x8){lo[0], lo[1], lo[2], lo[3], hi[0], hi[1], hi[2], hi[3]};
            }
            __builtin_amdgcn_sched_barrier(0);
#pragma unroll
            for (int dt = 0; dt < 4; ++dt) {
                oacc[dt][0] = __builtin_amdgcn_mfma_f32_16x16x32_bf16(vf[dt], pb[0], oacc[dt][0], 0, 0, 0);
                oacc[dt][1] = __builtin_amdgcn_mfma_f32_16x16x32_bf16(vf[dt], pb[1], oacc[dt][1], 0, 0, 0);
            }
            __builtin_amdgcn_sched_barrier(0);
        }
#pragma unroll
        for (int qt = 0; qt < 2; ++qt) {
            const int l = a.l0 + 64 * bi + 32 * half + 16 * qt + fr; const size_t tok = (size_t)a.tok0 + ((size_t)l << a.dsh) + a.p;
            const float inv = 1.0f / den[qt];
            bf16_t* op = QKV + ((size_t)((a.g * 3) * 8 + a.h) * T + tok) * 64 + 4 * fq;
#pragma unroll
            for (int dt = 0; dt < 4; ++dt) { u32x2 w; w.x = pk2(oacc[dt][qt][0] * inv, oacc[dt][qt][1] * inv); w.y = pk2(oacc[dt][qt][2] * inv, oacc[dt][qt][3] * inv); __builtin_nontemporal_store(w, (u32x2*)(op + 16 * dt)); }
            if (fq == 0) lse[tok * 24 + a.g * 8 + a.h] = (mx[qt] + __builtin_amdgcn_logf(den[qt])) * 0.6931471805599453f;
        }
    }
    LBAR();
}

DI void attn_combine_phase(const bf16_t* QKV, const float* lse, bf16_t* Y, int G, int bid) {
    int tid_ = threadIdx.x; asm volatile("" : "+v"(tid_)); asm volatile("" : "+s"(bid)); const int tid = tid_, wid = tid >> 6, lane = tid & 63;
    const int gw = bid * 8 + wid, NGW = G * 8;
    const int ts = lane >> 3, ch = lane & 7;
    for (int t8 = gw; t8 < T / 8; t8 += NGW) {
        const size_t tok = (size_t)t8 * 8 + ts;
        const float* lp = lse + tok * 24;
#pragma unroll 2
        for (int h = 0; h < 8; ++h) {
            const u32x4 o0 = __builtin_nontemporal_load((const u32x4*)(QKV + ((size_t)(0 * 8 + h) * T + tok) * 64 + ch * 8));
            const u32x4 o1 = __builtin_nontemporal_load((const u32x4*)(QKV + ((size_t)(3 * 8 + h) * T + tok) * 64 + ch * 8));
            const u32x4 o2 = __builtin_nontemporal_load((const u32x4*)(QKV + ((size_t)(6 * 8 + h) * T + tok) * 64 + ch * 8));
            const float l0 = lp[h], l1 = lp[8 + h], l2 = lp[16 + h];
            const float m = fmaxf(l0, fmaxf(l1, l2));
            float e0 = __expf(l0 - m), e1 = __expf(l1 - m), e2 = __expf(l2 - m);
            const float inv = 1.0f / (e0 + e1 + e2); e0 *= inv; e1 *= inv; e2 *= inv;
            u32x4 w;
#pragma unroll
            for (int i = 0; i < 4; ++i) {
                const float lo = e0 * bflo(o0[i]) + e1 * bflo(o1[i]) + e2 * bflo(o2[i]);
                const float hi = e0 * bfhi(o0[i]) + e1 * bfhi(o1[i]) + e2 * bfhi(o2[i]);
                w[i] = pk2(lo, hi);
            }
            *(u32x4*)(Y + tok * 512 + h * 64 + ch * 8) = w;
        }
    }
}

constexpr int MQ_STRIDE = 272, MV_STRIDE = 160;
constexpr int M_QS = 0, M_KS = 34816, M_VS = 69632, M_VWS = 90112, M_CS = 110592, M_SM = 132352;
DI float logsig(float x) { return fminf(x, 0.f) - log1pf(__expf(-fabsf(x))); }
DI bf16x8 tr_pair(const LAS unsigned char* p0, const LAS unsigned char* p1) {
    const s16x4 lo = __builtin_bit_cast(s16x4, __builtin_amdgcn_ds_read_tr16_b64_v4i16((LAS v4i16_t*)p0));
    const s16x4 hi = __builtin_bit_cast(s16x4, __builtin_amdgcn_ds_read_tr16_b64_v4i16((LAS v4i16_t*)p1));
    return (bf16x8){lo[0], lo[1], lo[2], lo[3], hi[0], hi[1], hi[2], hi[3]};
}
DI void mlstm_phase(LAS unsigned char* lds, const bf16_t* proj, const float* gates, bf16_t* Hfw, bf16_t* Hbw, int G, int bid) {
    int tid_ = threadIdx.x; asm volatile("" : "+v"(tid_)); asm volatile("" : "+s"(bid)); const int tid = tid_, wid = __builtin_amdgcn_readfirstlane(tid >> 6), lane = tid & 63, fr = lane & 15, fq = lane >> 4;
    LAS unsigned char* Qs = lds + M_QS; LAS unsigned char* Ks = lds + M_KS; LAS unsigned char* Vs = lds + M_VS; LAS unsigned char* VWs = lds + M_VWS; LAS unsigned char* Cs = lds + M_CS;
    LAS float* smal = (LAS float*)(lds + M_SM);
    for (int item = bid; item < 512; item += G) {
        const int it_ = item & 255; const bool lng = item < 256;
        const int it = ((((it_ >> 3) >> 2) * 8 + (it_ & 7)) << 2) | ((it_ >> 3) & 3);
        const int sl = it & 3, dir = (it >> 2) & 1, hh = (it >> 3) & 3, b = it >> 5;
        const int S = lng ? 8192 : 4096; const int tok0 = lng ? b * 8192 : TP + b * 4096; const int nc = S >> 7;
        bf16_t* Hout = dir ? Hbw : Hfw;
        const int gcol = dir * 8 + hh;
        LBAR();
        for (int i = tid; i < 80 * MQ_STRIDE / 4; i += 512) ((LAS unsigned*)Cs)[i] = 0u;
        if (tid < 128) { LAS unsigned* p = (LAS unsigned*)(Vs + tid * MV_STRIDE + 128); unsigned z = 0u; asm volatile("" : "+v"(z)); p[0] = 0x3F80u | z;
#pragma unroll
            for (int i = 1; i < 8; ++i) p[i] = z; }
        const int nown = (wid < 2) ? 2 : ((wid < 6) ? 1 : 0);
        f32x4 Creg[2][5];
#pragma unroll
        for (int dt = 0; dt < 5; ++dt) { Creg[0][dt] = (f32x4){0.f, 0.f, 0.f, 0.f}; Creg[1][dt] = Creg[0][dt]; }
        float mprev = 0.f;
        u32x4 pq[4], pk[4], pv[2]; float gi0 = 0.f, gi1 = 0.f, gf0 = 0.f, gf1 = 0.f;
#define MTOK(tau) ((size_t)tok0 + (size_t)(dir ? (S - 1 - (tau)) : (tau)))
#define MLOAD(c) do { \
            _Pragma("unroll") for (int i = 0; i < 4; ++i) { const int ci = tid + 512 * i, row = ci >> 4, ch = ci & 15; const bf16_t* rp = proj + MTOK((c) * 128 + row) * NPROJ; \
                pq[i] = *(const u32x4*)(rp + hh * 128 + ch * 8); pk[i] = *(const u32x4*)(rp + 512 + hh * 128 + ch * 8); } \
            _Pragma("unroll") for (int i = 0; i < 2; ++i) { const int ci = tid + 512 * i, row = ci >> 3, ch = ci & 7; const bf16_t* rp = proj + MTOK((c) * 128 + row) * NPROJ; \
                pv[i] = *(const u32x4*)(rp + 1024 + hh * 256 + sl * 64 + ch * 8); } } while (0)
#define GLOAD(c) do { const float* g0 = gates + MTOK((c) * 128 + 2 * lane) * 16; const float* g1 = gates + MTOK((c) * 128 + 2 * lane + 1) * 16; \
                gi0 = g0[gcol]; gf0 = g0[gcol + 4]; gi1 = g1[gcol]; gf1 = g1[gcol + 4]; } while (0)
#define GATES(bufi) do { LAS float* sa_ = smal + (bufi) * 388; LAS float* sM_ = sa_ + 128; LAS float* sb_ = sa_ + 256; LAS float* scl_ = sa_ + 384; \
                const float lf0 = logsig(gf0), lf1 = logsig(gf1); const float ps = lf0 + lf1; float inc = ps; \
                _Pragma("unroll") for (int o = 1; o < 64; o <<= 1) { const float t = __shfl_up(inc, o); if (lane >= o) inc += t; } \
                const float b0 = inc - ps + lf0, b1 = inc; const float a0 = gi0 - b0, a1 = gi1 - b1; float imx = fmaxf(a0, a1); \
                _Pragma("unroll") for (int o = 1; o < 64; o <<= 1) { const float t = __shfl_up(imx, o); if (lane >= o) imx = fmaxf(imx, t); } \
                float exm = __shfl_up(imx, 1); if (lane == 0) exm = -1e30f; \
                const float M0 = fmaxf(mprev, fmaxf(exm, a0)), M1 = fmaxf(mprev, imx); \
                sa_[2 * lane] = a0; sa_[2 * lane + 1] = a1; sM_[2 * lane] = M0; sM_[2 * lane + 1] = M1; sb_[2 * lane] = b0; sb_[2 * lane + 1] = b1; \
                const float M127_ = __shfl(M1, 63), b127_ = __shfl(b1, 63); \
                if (lane == 0) { scl_[0] = mprev; scl_[1] = M127_; } \
                mprev = b127_ + M127_; } while (0)
        MLOAD(0);
        if (wid == 2) { GLOAD(0); GATES(0); }
        LBAR();
        for (int c = 0; c < nc; ++c) {
            const int cur = c & 1;
            LAS float* sa = smal + cur * 388; LAS float* sM = sa + 128; LAS float* sb = sa + 256; LAS float* scl = sa + 384;
            const float mp = scl[0], M127 = scl[1];
#pragma unroll
            for (int i = 0; i < 4; ++i) { const int ci = tid + 512 * i, row = ci >> 4, ch = ci & 15;
                *(LAS u32x4*)(Qs + row * MQ_STRIDE + ch * 16) = pq[i]; *(LAS u32x4*)(Ks + row * MQ_STRIDE + ch * 16) = pk[i]; }
#pragma unroll
            for (int i = 0; i < 2; ++i) { const int ci = tid + 512 * i, row = ci >> 3, ch = ci & 7;
                *(LAS u32x4*)(Vs + row * MV_STRIDE + ch * 16) = pv[i];
                const float wsv = __expf(sa[row] - M127);
                u32x4 w;
#pragma unroll
                for (int e = 0; e < 4; ++e) w[e] = pk2(bflo(pv[i][e]) * wsv, bfhi(pv[i][e]) * wsv);
                *(LAS u32x4*)(VWs + row * MV_STRIDE + ch * 16) = w;
                if (ch == 0) { const u32x4 x0 = {pk2(wsv, 0.f), 0u, 0u, 0u}, x1 = {0u, 0u, 0u, 0u};
                    *(LAS u32x4*)(VWs + row * MV_STRIDE + 128) = x0; *(LAS u32x4*)(VWs + row * MV_STRIDE + 144) = x1; }
            }
            if (c + 1 < nc) { MLOAD(c + 1); if (wid == 2) GLOAD(c + 1); }
            LBAR();
            {
                const int t = 16 * wid + fr;
                bf16x8 qf[4];
#pragma unroll
                for (int ks = 0; ks < 4; ++ks) qf[ks] = *(const LAS bf16x8*)(Qs + t * MQ_STRIDE + ks * 64 + fq * 16);
                const float Mt = sM[t], bt = sb[t];
                f32x4 nacc[5];
                {
                    bf16x8 cf[2][4];
#pragma unroll
                    for (int dt = 0; dt < 5; ++dt) nacc[dt] = (f32x4){0.f, 0.f, 0.f, 0.f};
#pragma unroll
                    for (int db = 0; db < 3; ++db) {
#pragma unroll
                        for (int dt = 0; dt < 2; ++dt)
#pragma unroll
                            for (int ks = 0; ks < 4; ++ks) if (2 * db + dt < 5) cf[dt][ks] = *(const LAS bf16x8*)(Cs + (16 * (2 * db + dt) + fr) * MQ_STRIDE + ks * 64 + fq * 16);
                        __builtin_amdgcn_sched_barrier(0);
#pragma unroll
                        for (int ks = 0; ks < 4; ++ks)
#pragma unroll
                            for (int dt = 0; dt < 2; ++dt) if (2 * db + dt < 5) nacc[2 * db + dt] = __builtin_amdgcn_mfma_f32_16x16x32_bf16(cf[dt][ks], qf[ks], nacc[2 * db + dt], 0, 0, 0);
                        __builtin_amdgcn_sched_barrier(0);
                    }
                }
                const float inter = __expf(mp - Mt);
#pragma unroll
                for (int dt = 0; dt < 5; ++dt) nacc[dt] = nacc[dt] * inter;
#pragma unroll
                for (int jj = 0; jj < 4; ++jj) {
                    if (2 * jj <= wid) {
                        f32x4 s0 = {0.f, 0.f, 0.f, 0.f}, s1 = s0;
                        bf16x8 k0[4], k1[4], vfr[5];
                        const int vr = 32 * jj + 4 * fq + (fr >> 2);
#pragma unroll
                        for (int ks = 0; ks < 4; ++ks) {
                            k0[ks] = *(const LAS bf16x8*)(Ks + (32 * jj + fr) * MQ_STRIDE + ks * 64 + fq * 16);
                            k1[ks] = *(const LAS bf16x8*)(Ks + (32 * jj + 16 + fr) * MQ_STRIDE + ks * 64 + fq * 16);
                        }
                        __builtin_amdgcn_sched_barrier(0);
#pragma unroll
                        for (int ks = 0; ks < 4; ++ks) {
                            s0 = __builtin_amdgcn_mfma_f32_16x16x32_bf16(k0[ks], qf[ks], s0, 0, 0, 0);
                            s1 = __builtin_amdgcn_mfma_f32_16x16x32_bf16(k1[ks], qf[ks], s1, 0, 0, 0);
                        }
                        __builtin_amdgcn_sched_barrier(0);
#pragma unroll
                        for (int dt = 0; dt < 5; ++dt) vfr[dt] = tr_pair(Vs + vr * MV_STRIDE + (16 * dt + 4 * (fr & 3)) * 2, Vs + (vr + 16) * MV_STRIDE + (16 * dt + 4 * (fr & 3)) * 2);
                        const f32x4 a0 = *(const LAS f32x4*)(sa + 32 * jj + 4 * fq), a1 = *(const LAS f32x4*)(sa + 32 * jj + 16 + 4 * fq);
#pragma unroll
                        for (int i = 0; i < 4; ++i) {
                            const int sA = 32 * jj + 4 * fq + i, sB = sA + 16;
                            s0[i] = (sA <= t) ? s0[i] * __expf(a0[i] - Mt) : 0.f;
                            s1[i] = (sB <= t) ? s1[i] * __expf(a1[i] - Mt) : 0.f;
                        }
                        u32x4 w; w.x = pk2(s0[0], s0[1]); w.y = pk2(s0[2], s0[3]); w.z = pk2(s1[0], s1[1]); w.w = pk2(s1[2], s1[3]);
                        const bf16x8 pb = __builtin_bit_cast(bf16x8, w);
#pragma unroll
                        for (int dt = 0; dt < 5; ++dt) nacc[dt] = __builtin_amdgcn_mfma_f32_16x16x32_bf16(vfr[dt], pb, nacc[dt], 0, 0, 0);
                    }
                }
                const float dn = __shfl(nacc[4][0], fr);
                const float dd = fmaxf(fabsf(dn), __expf(-(bt + Mt)));
                const float inv = 1.0f / dd;
                bf16_t* op = Hout + MTOK(c * 128 + t) * D + hh * 256 + sl * 64 + 4 * fq;
#pragma unroll
                for (int dt = 0; dt < 4; ++dt) { u32x2 w; w.x = pk2(nacc[dt][0] * inv, nacc[dt][1] * inv); w.y = pk2(nacc[dt][2] * inv, nacc[dt][3] * inv); __builtin_nontemporal_store(w, (u32x2*)(op + 16 * dt)); }
            }
            if (nown > 0) {
                const float decay = __expf(mp - M127);
#pragma unroll
                for (int dt = 0; dt < 5; ++dt) { Creg[0][dt] = Creg[0][dt] * decay; Creg[1][dt] = Creg[1][dt] * decay; }
#pragma unroll
                for (int jj = 0; jj < 4; ++jj) {
                    bf16x8 kb0, kb1, af[5];
                    const int sr = 32 * jj + 4 * fq + (fr >> 2);
                    kb0 = tr_pair(Ks + sr * MQ_STRIDE + (16 * wid + 4 * (fr & 3)) * 2, Ks + (sr + 16) * MQ_STRIDE + (16 * wid + 4 * (fr & 3)) * 2);
                    kb1 = kb0;
                    if (nown == 2) kb1 = tr_pair(Ks + sr * MQ_STRIDE + (16 * (wid + 6) + 4 * (fr & 3)) * 2, Ks + (sr + 16) * MQ_STRIDE + (16 * (wid + 6) + 4 * (fr & 3)) * 2);
#pragma unroll
                    for (int dt = 0; dt < 5; ++dt) af[dt] = tr_pair(VWs + sr * MV_STRIDE + (16 * dt + 4 * (fr & 3)) * 2, VWs + (sr + 16) * MV_STRIDE + (16 * dt + 4 * (fr & 3)) * 2);
                    __builtin_amdgcn_sched_barrier(0);
#pragma unroll
                    for (int dt = 0; dt < 5; ++dt) Creg[0][dt] = __builtin_amdgcn_mfma_f32_16x16x32_bf16(af[dt], kb0, Creg[0][dt], 0, 0, 0);
                    if (nown == 2) {
#pragma unroll
                        for (int dt = 0; dt < 5; ++dt) Creg[1][dt] = __builtin_amdgcn_mfma_f32_16x16x32_bf16(af[dt], kb1, Creg[1][dt], 0, 0, 0);
                    }
                    __builtin_amdgcn_sched_barrier(0);
                }
            }
            if (wid == 2 && c + 1 < nc) GATES(cur ^ 1);
            LBAR();
            if (nown > 0) {
#pragma unroll
                for (int dt = 0; dt < 5; ++dt)
#pragma unroll
                    for (int i = 0; i < 4; ++i)
                        *(LAS bf16_t*)(Cs + (16 * dt + 4 * fq + i) * MQ_STRIDE + (16 * wid + fr) * 2) = (bf16_t)(pk2(Creg[0][dt][i], 0.f) & 0xffffu);
                if (nown == 2) {
#pragma unroll
                    for (int dt = 0; dt < 5; ++dt)
#pragma unroll
                        for (int i = 0; i < 4; ++i)
                            *(LAS bf16_t*)(Cs + (16 * dt + 4 * fq + i) * MQ_STRIDE + (16 * (wid + 6) + fr) * 2) = (bf16_t)(pk2(Creg[1][dt][i], 0.f) & 0xffffu);
                }
            }
        }
#undef MLOAD
#undef GLOAD
#undef GATES
#undef MTOK
    }
    LBAR();
}

DI void mlstm_combine_phase(bf16_t* Hfw, const bf16_t* Hbw, const bf16_t* proj, const float* hn, int G, int bid) {
    int tid_ = threadIdx.x; asm volatile("" : "+v"(tid_)); asm volatile("" : "+s"(bid)); const int tid = tid_, wid = tid >> 6, lane = tid & 63;
    const int gw = bid * 8 + wid, NGW = G * 8;
    for (int row = gw; row < T; row += NGW) {
        bf16_t* fp = Hfw + (size_t)row * D + 16 * lane; const bf16_t* bp = Hbw + (size_t)row * D + 16 * lane; const bf16_t* op = proj + (size_t)row * NPROJ + 2048 + 16 * lane;
        float hs[16], ov[16]; float ss = 0.f;
#pragma unroll
        for (int q = 0; q < 2; ++q) {
            const u32x4 f = __builtin_nontemporal_load((const u32x4*)(fp + 8 * q)), b = __builtin_nontemporal_load((const u32x4*)(bp + 8 * q)), o = __builtin_nontemporal_load((const u32x4*)(op + 8 * q));
#pragma unroll
            for (int i = 0; i < 4; ++i) {
                hs[8 * q + 2 * i] = bflo(f[i]) + bflo(b[i]); hs[8 * q + 2 * i + 1] = bfhi(f[i]) + bfhi(b[i]);
                ov[8 * q + 2 * i] = bflo(o[i]); ov[8 * q + 2 * i + 1] = bfhi(o[i]);
            }
        }
#pragma unroll
        for (int i = 0; i < 16; ++i) ss += hs[i] * hs[i];
        ss += __shfl_xor(ss, 1); ss += __shfl_xor(ss, 2); ss += __shfl_xor(ss, 4); ss += __shfl_xor(ss, 8);
        const float rstd = rsqrtf(ss * (1.0f / 256.0f) + RMS_EPS);
#pragma unroll
        for (int q = 0; q < 2; ++q) {
            u32x4 w;
#pragma unroll
            for (int i = 0; i < 4; ++i) {
                const int e = 8 * q + 2 * i;
                const float y0 = hs[e] * rstd * hn[16 * lane + e] / (1.0f + __expf(-ov[e]));
                const float y1 = hs[e + 1] * rstd * hn[16 * lane + e + 1] / (1.0f + __expf(-ov[e + 1]));
                w[i] = pk2(y0, y1);
            }
            *(u32x4*)(fp + 8 * q) = w;
        }
    }
}

#define XB_TMO      128
#define XB_XCNT(j)  (256  + 64 * (j))
#define XB_XSUB(j)  (1280 + 64 * (j))
#define XB_XGEN(j)  (2304 + 64 * (j))
#define XB_TOP      3328
#define XB_TOPGEN   3392
#define XCD_BAR_WORDS 3456
#define XB_SPIN_CAP (1u << 18)
DI unsigned xb_ld(unsigned* p)              { return __hip_atomic_load(p, __ATOMIC_RELAXED, __HIP_MEMORY_SCOPE_AGENT); }
DI unsigned xb_add(unsigned* p, unsigned v) { return __hip_atomic_fetch_add(p, v, __ATOMIC_RELAXED, __HIP_MEMORY_SCOPE_AGENT); }
DI unsigned xb_xcc_id() { return (unsigned)__builtin_amdgcn_s_getreg((3 << 11) | 20) & 0xFu; }
#define XB_SPIN(cond, bar) do { unsigned _sp = 0; while (cond) { __builtin_amdgcn_s_sleep(1); \
    if ((++_sp & 255u) == 0u) { if (xb_ld(&(bar)[XB_TMO])) break; if (_sp > XB_SPIN_CAP) { atomicAdd(&(bar)[XB_TMO], 1u); break; } } } } while (0)
struct XcdBarrier { unsigned* bar; unsigned x; volatile LAS unsigned* st; };
DI XcdBarrier xcd_barrier_post(unsigned* bar, volatile LAS unsigned* st) {
    XcdBarrier b; b.bar = bar; b.x = xb_xcc_id(); b.st = st;
    if (threadIdx.x == 0) (void)xb_add(&bar[XB_XCNT(b.x)], 1u);
    return b;
}
DI void xcd_barrier_complete(unsigned* bar, unsigned x, unsigned& nloc, unsigned& nx) {
    const unsigned G = gridDim.x * gridDim.y * gridDim.z;
    unsigned sum, cnt, mine, sp = 0u;
    for (;;) {
        sum = 0u; cnt = 0u; mine = 0u;
#pragma unroll
        for (unsigned j = 0; j < 16; ++j) { const unsigned c = xb_ld(&bar[XB_XCNT(j)]); sum += c; cnt += (c > 0u) ? 1u : 0u; mine = (j == x) ? c : mine; }
        if (sum == G) break;
        __builtin_amdgcn_s_sleep(1);
        if ((++sp & 255u) == 0u) { if (xb_ld(&bar[XB_TMO])) break; if (sp > XB_SPIN_CAP) { atomicAdd(&bar[XB_TMO], 1u); break; } }
    }
    nloc = mine > 0u ? mine : 1u; nx = cnt > 0u ? cnt : 1u;
}
DI void xcd_barrier(const XcdBarrier& b) {
    asm volatile("s_waitcnt vmcnt(0)" ::: "memory");
    __syncthreads();
    if (threadIdx.x == 0) {
        unsigned* bar = b.bar;
        __builtin_amdgcn_s_waitcnt(0);
        unsigned nloc = b.st[0], nx = b.st[1];
        if (nloc == 0u) { xcd_barrier_complete(bar, b.x, nloc, nx); b.st[0] = nloc; b.st[1] = nx; }
        const unsigned old = xb_add(&bar[XB_XSUB(b.x)], 1u);
        const unsigned gen = old / nloc;
        if (old + 1u == (gen + 1u) * nloc) {
            __builtin_amdgcn_fence(__ATOMIC_RELEASE, "agent");
            asm volatile("s_waitcnt vmcnt(0)" ::: "memory");
            const unsigned og = xb_add(&bar[XB_TOP], 1u);
            const unsigned tg = og / nx;
            if (og + 1u == (tg + 1u) * nx) xb_add(&bar[XB_TOPGEN], 1u);
            else XB_SPIN(xb_ld(&bar[XB_TOPGEN]) == tg, bar);
            __builtin_amdgcn_fence(__ATOMIC_ACQUIRE, "agent");
            xb_add(&bar[XB_XGEN(b.x)], 1u);
            asm volatile("s_waitcnt vmcnt(0)" ::: "memory");
        } else {
            XB_SPIN(xb_ld(&bar[XB_XGEN(b.x)]) == gen, bar);
            __builtin_amdgcn_fence(__ATOMIC_ACQUIRE, "agent");
            asm volatile("s_waitcnt vmcnt(0)" ::: "memory");
        }
    }
    __syncthreads();
}

__global__ void __launch_bounds__(512, 2) fwd_megakernel(Args args) {
    extern __shared__ __attribute__((aligned(16))) unsigned char lds_raw[];
    LAS unsigned char* lds = (LAS unsigned char*)lds_raw;
    cg::grid_group grid = cg::this_grid();
    if (threadIdx.x < 16) ((LAS unsigned*)(lds + LDS_BYTES - 64))[threadIdx.x] = 0u;
    __syncthreads();
    const XcdBarrier xbar = xcd_barrier_post((unsigned*)(args.ws + WS_BAR), (volatile LAS unsigned*)(lds + LDS_BYTES - 64));
    const int G = gridDim.x, bid = blockIdx.x;
    unsigned char* ws = args.ws;
    float* mod = (float*)(ws + WS_MOD);
    float* xout = args.out;
    const float* xin_p = args.in[0]; const float* xin_s = args.in[1] - (size_t)TP * D;

#ifndef REP_GEMM
#define REP_GEMM 1
#endif
#ifndef REP_MLSTM
#define REP_MLSTM 1
#endif
#ifndef REP_NORM
#define REP_NORM 1
#endif
#define GEMM_PHASE(MODE, Aptr, Bptr, LDA, KK, NN, EPI) do { pg8::Gemm gm{(const bf16_t*)(Aptr), (const bf16_t*)(Bptr), (LDA), (KK), T, (NN)}; pg8::StaticOrder S; S.init(T, (NN), G, bid); \
        pg8::gemm_phase<MODE>(lds, gm, S, EPI); } while (0)
    const float* rope = (const float*)(ws + WS_ROPE);
    float* mod1 = mod + 16 * 6144;
    unsigned long long* rowq = (unsigned long long*)(ws + WS_ROWQ);
    float* lse = xout + OUT_LSE / 4;
#define EPI0(O_, ROPE_) pg8::Epi{(O_), (ROPE_), nullptr, nullptr, nullptr, nullptr, nullptr, nullptr, nullptr, nullptr, nullptr, nullptr, nullptr, nullptr, nullptr, 0}
#define EPI1(BP, BS, GT, ID, NG, NSH, NSC, HOUT, FIN) pg8::Epi{nullptr, nullptr, (BP), (BS), xout, (GT), nullptr, nullptr, nullptr, nullptr, rowq + (size_t)(ID) * T, (NG), (NSH), (NSC), (HOUT), (FIN)}
#ifdef PROBE_SYNC
    for (int i = 0; i < 20; ++i) grid.sync();
#endif
    prologue(lds, args, G, bid);
    if (G == 0x7fffffff) grid.sync();
    xcd_barrier(xbar);
    for (int rep = 0; rep < REP_NORM; ++rep) { normmod_phase(xin_p, xin_s, args.in[6], mod + 0, mod + 1024, (bf16_t*)xout, G, bid); if (rep + 1 < REP_NORM) xcd_barrier(xbar); }
    xcd_barrier(xbar);
    { pg8::Epi E = EPI0((bf16_t*)(ws + WS_R), rope);
      for (int rep = 0; rep < REP_GEMM; ++rep) { GEMM_PHASE(0, xout, ws + WS_WQKV, D, D, NQKV, E); if (rep + 1 < REP_GEMM) xcd_barrier(xbar); } }
    xcd_barrier(xbar);
    attn_phase(lds, (bf16_t*)(ws + WS_R), lse, G, bid);
    xcd_barrier(xbar);
    for (int rep = 0; rep < REP_NORM; ++rep) { attn_combine_phase((const bf16_t*)(ws + WS_R), lse, (bf16_t*)(ws + WS_Y), G, bid); if (rep + 1 < REP_NORM) xcd_barrier(xbar); }
    xcd_barrier(xbar);
    { pg8::Epi E = EPI1(xin_p, xin_s, mod + 2048, 0, args.in[9], mod + 3072, mod + 4096, (bf16_t*)(ws + WS_R), 0);
      GEMM_PHASE(1, ws + WS_Y, ws + WS_WO, 512, 512, D, E); }
    xcd_barrier(xbar);
    { pg8::Epi E = EPI0((bf16_t*)(ws + WS_B), nullptr);
      for (int rep = 0; rep < REP_GEMM; ++rep) { GEMM_PHASE(2, ws + WS_R, ws + WS_WGU0, D, D, NGU, E); if (rep + 1 < REP_GEMM) xcd_barrier(xbar); } }
    xcd_barrier(xbar);
    { pg8::Epi E = EPI1(xout, xout, mod + 5120, 1, args.in[14], mod1 + 0, mod1 + 1024, (bf16_t*)(ws + WS_R), 0);
      GEMM_PHASE(1, ws + WS_B, ws + WS_WDN0, FFH, FFH, D, E); }
    xcd_barrier(xbar);
    { pg8::Epi E = EPI0((bf16_t*)(ws + WS_B), nullptr); E.gates = (float*)(ws + WS_GATES); E.bg = args.in[16]; E.A3 = (const bf16_t*)(ws + WS_R); E.Wg = (const bf16_t*)(ws + WS_WIN) + (size_t)NPROJ * D;
      for (int rep = 0; rep < REP_GEMM; ++rep) { GEMM_PHASE(3, ws + WS_R, ws + WS_WIN, D, D, NPROJ, E); if (rep + 1 < REP_GEMM) xcd_barrier(xbar); } }
    xcd_barrier(xbar);
    for (int rep = 0; rep < REP_MLSTM; ++rep) { mlstm_phase(lds, (const bf16_t*)(ws + WS_B), (const float*)(ws + WS_GATES), (bf16_t*)(ws + WS_R), (bf16_t*)(ws + WS_HBW), G, bid); if (rep + 1 < REP_MLSTM) xcd_barrier(xbar); }
    xcd_barrier(xbar);
    mlstm_combine_phase((bf16_t*)(ws + WS_R), (const bf16_t*)(ws + WS_HBW), (const bf16_t*)(ws + WS_B), args.in[17], G, bid);
    xcd_barrier(xbar);
    { pg8::Epi E = EPI1(xout, xout, mod1 + 2048, 2, args.in[19], mod1 + 3072, mod1 + 4096, (bf16_t*)(ws + WS_B), 0);
      GEMM_PHASE(1, ws + WS_R, ws + WS_WOUT, D, D, D, E); }
    xcd_barrier(xbar);
    { pg8::Epi E = EPI0((bf16_t*)(ws + WS_HID1), nullptr);
      for (int rep = 0; rep < REP_GEMM; ++rep) { GEMM_PHASE(2, ws + WS_B, ws + WS_WGU1, D, D, NGU, E); if (rep + 1 < REP_GEMM) xcd_barrier(xbar); } }
    xcd_barrier(xbar);
    { pg8::Epi E = EPI1(xout, xout, mod1 + 5120, 3, args.in[22], nullptr, nullptr, nullptr, 1);
      GEMM_PHASE(1, ws + WS_HID1, ws + WS_WDN1, FFH, FFH, D, E); }
}

extern "C" void kernel_launch(void* const* d_in, const int* in_sizes, int n_in, void* d_out, int out_size, void* d_ws, size_t ws_size, hipStream_t stream) {
    static int grid = 0;
    if (grid == 0) {
        if (n_in != 23 || out_size != T * D || ws_size < WS_NEED) { fprintf(stderr, "kernel_launch: unexpected shapes (n_in %d out %d ws %zu)\n", n_in, out_size, ws_size); grid = -1; return; }
        int dev = 0, cus = 0, per_cu = 0;
        hipGetDevice(&dev);
        hipDeviceGetAttribute(&cus, hipDeviceAttributeMultiprocessorCount, dev);
        hipFuncSetAttribute((const void*)fwd_megakernel, hipFuncAttributeMaxDynamicSharedMemorySize, LDS_BYTES);
        hipOccupancyMaxActiveBlocksPerMultiprocessor(&per_cu, (const void*)fwd_megakernel, 512, LDS_BYTES);
        if (per_cu < 1) per_cu = 1;
        grid = cus * per_cu;
        (void)hipGetLastError();
    }
    if (grid < 0) return;
    hipMemsetAsync((char*)d_ws + WS_MOD, 0, WS_ZERO_BYTES, stream);
    Args a{};
    for (int i = 0; i < 23; ++i) a.in[i] = (const float*)d_in[i];
    a.out = (float*)d_out; a.ws = (unsigned char*)d_ws;
    void* kargs[] = {&a};
    hipError_t e = hipLaunchCooperativeKernel((const void*)fwd_megakernel, dim3(grid), dim3(512), kargs, LDS_BYTES, stream);
    if (e != hipSuccess) fprintf(stderr, "cooperative launch failed: %s (grid %d)\n", hipGetErrorString(e), grid);
}
```

```cpp
#include <hip/hip_runtime.h>
#include <hip/hip_cooperative_groups.h>
#include <cstdio>
#include <cstdint>
namespace cg = cooperative_groups;

#define LAS __attribute__((address_space(3)))
#define DI __device__ __forceinline__
typedef unsigned short bf16_t;
typedef short bf16x8 __attribute__((ext_vector_type(8)));
typedef short s16x4 __attribute__((ext_vector_type(4)));
typedef float f32x4 __attribute__((ext_vector_type(4)));
typedef float f32x2 __attribute__((ext_vector_type(2)));
typedef unsigned u32x4 __attribute__((ext_vector_type(4)));
typedef unsigned u32x2 __attribute__((ext_vector_type(2)));
typedef __bf16 bf16x2_t __attribute__((ext_vector_type(2)));
typedef short v4i16_t __attribute__((ext_vector_type(4)));

DI unsigned pk2(float lo, float hi) { f32x2 v = {lo, hi}; bf16x2_t b = __builtin_convertvector(v, bf16x2_t); return __builtin_bit_cast(unsigned, b); }
DI float bflo(unsigned u) { return __uint_as_float(u << 16); }
DI float bfhi(unsigned u) { return __uint_as_float(u & 0xffff0000u); }
DI float wave_sum(float v) {
#pragma unroll
    for (int o = 1; o < 64; o <<= 1) v += __shfl_xor(v, o);
    return v;
}
#define LBAR() do { asm volatile("s_waitcnt lgkmcnt(0)" ::: "memory"); __builtin_amdgcn_s_barrier(); asm volatile("" ::: "memory"); } while (0)

constexpr int D = 1024, TP = 65536, TSM = 32768, T = TP + TSM;
constexpr int NQKV = 4608, FFH = 2816, NGU = 5632, NIN = 3088, NINP = 3328, NPROJ = 3072;
constexpr float RMS_EPS = 1e-6f;
constexpr size_t MiB = 1u << 20;
constexpr size_t WS_MOD = 0;
constexpr size_t WS_BAR = 0xC4000;
constexpr size_t WS_ROWQ = 1 * MiB;
constexpr size_t WS_ZERO_BYTES = 4 * MiB;
constexpr size_t WS_ROPE = 4 * MiB;
constexpr size_t WS_WIN = 5 * MiB, WS_WOUT = 12 * MiB, WS_WGU1 = 14 * MiB, WS_WDN1 = 25 * MiB;
constexpr size_t WS_WQKV = 31 * MiB, WS_WO = 40 * MiB, WS_WGU0 = 41 * MiB, WS_WDN0 = 52 * MiB;
constexpr size_t WS_GATES = 31 * MiB;
constexpr size_t WS_R = 58 * MiB;
constexpr size_t WS_Y = 922 * MiB;
constexpr size_t WS_B = 250 * MiB;
constexpr size_t WS_HID1 = 442 * MiB;
constexpr size_t WS_HBW = 826 * MiB;
constexpr size_t WS_NEED = 1018 * MiB;
constexpr size_t OUT_LSE = 192 * MiB;
constexpr int LDS_BYTES = 147456;

DI int batch_of_row(int r) { return r < TP ? (r >> 13) : 8 + ((r - TP) >> 12); }
DI int pos_of_row(int r) { return r < TP ? (r & 8191) : ((r - TP) & 4095); }

namespace pg8 {
constexpr int BM = 256, BK = 64, HALF = 128, HTB = HALF * BK * 2, NXCD = 8, WGM = 8;
DI int lds_byte(int r, int c) { const int st = (r >> 4) * 2 + (c >> 5), rr = r & 15, cc = c & 31, ob = rr * 64 + cc * 2; return st * 1024 + (ob ^ (((ob >> 9) & 1) << 5)); }
DI void stage_rc(int b, int& R, int& C) { const int st = b / 1024, sb = b % 1024, swz = sb ^ (((sb >> 9) & 1) << 5); R = (st >> 1) * 16 + swz / 64; C = (st & 1) * 32 + (swz % 64) / 2; }
DI int perm32(int rho) { const int n = rho >> 4, i = rho & 15; return 8 * (i >> 2) + 4 * n + (i & 3); }
struct Unit { int pm, pn; };
struct Gemm { const bf16_t* A; const bf16_t* Bt; int lda, K, M, N; };
struct StaticOrder {
    int nM, nN, nwg, G, c;
    DI void init(int M, int N, int G_, int c_) { nM = M / BM; nN = N / BM; nwg = nM * nN; G = G_; c = c_; }
    DI bool next(int i, Unit& u) const {
        const long L = (long)i * G + c; if (L >= nwg) return false;
        int wgid = (int)L; { const int q = nwg / NXCD, r = nwg % NXCD, xcd = wgid % NXCD, off = wgid / NXCD; wgid = (xcd < r ? xcd * (q + 1) : r * (q + 1) + (xcd - r) * q) + off; }
        const int nig = WGM * nN, gid = wgid / nig, fm = gid * WGM, gsz = (nM - fm) < WGM ? (nM - fm) : WGM;
        u.pm = fm + ((wgid % nig) % gsz); u.pn = (wgid % nig) / gsz; return true;
    }
};

struct Epi {
    bf16_t* O;
    const float* rope;
    const float* base_p; const float* base_s; float* out; const float* gt;
    float* gates; const float* bg; const bf16_t* A3; const bf16_t* Wg;
    unsigned long long* rowq; const float* ng; const float* nsh; const float* nsc; bf16_t* hout; int fin;
};
DI float silu_f(float a) { return a * __builtin_amdgcn_rcpf(1.0f + __builtin_amdgcn_exp2f(-1.4426950408889634f * a)); }
template <int MODE> DI void epilogue(const Epi& E, f32x4 (&acc)[2][2][4][2], const Unit& u, int wr, int wc, int fr, int fq) {
    const int row0 = u.pm * BM + wr * 64 + fr;
    constexpr int emode = MODE;
    if constexpr (emode == 0) {
        const int colt = u.pn * BM; const int typ = (colt % 1536) >> 9;
        const bool rp = (typ < 2);
#pragma unroll
        for (int ai = 0; ai < 2; ++ai)
#pragma unroll
            for (int m = 0; m < 4; ++m) {
                const int row = row0 + ai * HALF + m * 16; const int pos = pos_of_row(row);
                f32x4 c0 = {1.f, 1.f, 1.f, 1.f}, c1 = c0, s0 = {0.f, 0.f, 0.f, 0.f}, s1 = s0;
                if (rp) { const f32x4* rt = (const f32x4*)(E.rope + (size_t)pos * 16); c0 = rt[0]; c1 = rt[1]; s0 = rt[2]; s1 = rt[3]; }
                const int pl0 = ((colt / 1536) * 3 + typ) * 8;
#pragma unroll
                for (int bj = 0; bj < 2; ++bj) {
                    const int hh_ = (((colt & 511) + wc * 64) >> 6);
                    bf16_t* rowp = E.O + ((size_t)(pl0 + hh_) * T + row) * 64 + bj * 32 + 8 * fq;
                    f32x4 v0 = acc[ai][bj][m][0], v1 = acc[ai][bj][m][1];
                    if (rp && bj == 0) {
                        f32x4 p0, p1;
#pragma unroll
                        for (int e = 0; e < 4; ++e) { p0[e] = __shfl_xor(v0[e], 16); p1[e] = __shfl_xor(v1[e], 16); }
                        if (fq == 0) { v0 = v0 * c0 - p0 * s0; v1 = v1 * c1 - p1 * s1; }
                        else if (fq == 1) { v0 = v0 * c0 + p0 * s0; v1 = v1 * c1 + p1 * s1; }
                    }
                    u32x4 w; w.x = pk2(v0[0], v0[1]); w.y = pk2(v0[2], v0[3]); w.z = pk2(v1[0], v1[1]); w.w = pk2(v1[2], v1[3]);
                    __builtin_nontemporal_store(w, (u32x4*)rowp);
                }
            }
    } else if constexpr (emode == 1) {
        const int bidx = batch_of_row(u.pm * BM);
        const char* base = (const char*)((u.pm * BM < TP) ? E.base_p : E.base_s);
        const int col0 = u.pn * BM + wc * 64 + 8 * fq;
        const unsigned ro = ((unsigned)row0 * D + (unsigned)col0) * 4u;
#define E1_OFF(ai, m, bj) (ro + (unsigned)(((ai) * HALF + (m) * 16) * D * 4 + (bj) * 32 * 4))
#pragma unroll
        for (int bj = 0; bj < 2; ++bj) {
            const f32x4 g0 = *(const f32x4*)(E.gt + bidx * 6144 + col0 + bj * 32), g1 = *(const f32x4*)(E.gt + bidx * 6144 + col0 + bj * 32 + 4);
#pragma unroll
            for (int ai = 0; ai < 2; ++ai)
#pragma unroll
                for (int m = 0; m < 4; ++m) {
                    const unsigned off = E1_OFF(ai, m, bj);
                    const f32x4 b0 = __builtin_nontemporal_load((const f32x4*)(base + off)), b1 = __builtin_nontemporal_load((const f32x4*)(base + off + 16));
                    acc[ai][bj][m][0] = b0 + g0 * acc[ai][bj][m][0];
                    acc[ai][bj][m][1] = b1 + g1 * acc[ai][bj][m][1];
                    asm volatile("" : "+v"(acc[ai][bj][m][0]), "+v"(acc[ai][bj][m][1]));
                }
            asm volatile("" ::: "memory");
        }
#pragma unroll
        for (int ai = 0; ai < 2; ++ai)
#pragma unroll
            for (int m = 0; m < 4; ++m) {
                float sq = 0.f;
#pragma unroll
                for (int bj = 0; bj < 2; ++bj)
#pragma unroll
                    for (int n = 0; n < 2; ++n) { const f32x4 v = acc[ai][bj][m][n]; sq += (v.x * v.x + v.y * v.y) + (v.z * v.z + v.w * v.w); }
                sq += __shfl_xor(sq, 16); sq += __shfl_xor(sq, 32);
                if (fq == 0) __hip_atomic_fetch_add(E.rowq + row0 + ai * HALF + m * 16, (1ull << 52) + (unsigned long long)(sq * 65536.0f + 0.5f), __ATOMIC_RELAXED, __HIP_MEMORY_SCOPE_AGENT);
            }
        if (!E.fin) {
            char* outp = (char*)E.out;
#pragma unroll
            for (int bj = 0; bj < 2; ++bj)
#pragma unroll
                for (int ai = 0; ai < 2; ++ai)
#pragma unroll
                    for (int m = 0; m < 4; ++m) {
                        const unsigned off = E1_OFF(ai, m, bj);
                        __builtin_nontemporal_store(acc[ai][bj][m][0], (f32x4*)(outp + off)); __builtin_nontemporal_store(acc[ai][bj][m][1], (f32x4*)(outp + off + 16));
                    }
        }
        float rs[2][4];
        { unsigned sp = 0;
          for (;;) {
              const unsigned long long ql = __hip_atomic_load(E.rowq + row0 + HALF + 48, __ATOMIC_RELAXED, __HIP_MEMORY_SCOPE_AGENT);
              if (__all((ql >> 52) >= 16ull)) {
                  bool done = true;
#pragma unroll
                  for (int ai = 0; ai < 2; ++ai)
#pragma unroll
                      for (int m = 0; m < 4; ++m) {
                          const unsigned long long q = __hip_atomic_load(E.rowq + row0 + ai * HALF + m * 16, __ATOMIC_RELAXED, __HIP_MEMORY_SCOPE_AGENT);
                          done = done && ((q >> 52) >= 16ull);
                          rs[ai][m] = rsqrtf((float)(q & ((1ull << 52) - 1ull)) * (1.0f / 65536.0f) * (1.0f / D) + RMS_EPS);
                      }
                  if (__all(done)) break;
              }
              __builtin_amdgcn_s_sleep(4);
              if (++sp > (1u << 18)) {
#pragma unroll
                  for (int ai = 0; ai < 2; ++ai)
#pragma unroll
                      for (int m = 0; m < 4; ++m) rs[ai][m] = 0.f;
                  break; }
          } }
#pragma unroll
        for (int bj = 0; bj < 2; ++bj) {
            const int c = col0 + bj * 32;
            f32x4 ga = *(const f32x4*)(E.ng + c), gb = *(const f32x4*)(E.ng + c + 4);
            f32x4 sha = {0.f, 0.f, 0.f, 0.f}, shb = sha;
            if (!E.fin) {
                const f32x4 sca = *(const f32x4*)(E.nsc + bidx * 6144 + c), scb = *(const f32x4*)(E.nsc + bidx * 6144 + c + 4);
                sha = *(const f32x4*)(E.nsh + bidx * 6144 + c); shb = *(const f32x4*)(E.nsh + bidx * 6144 + c + 4);
                ga = ga * (sca + 1.0f); gb = gb * (scb + 1.0f);
            }
#pragma unroll
            for (int ai = 0; ai < 2; ++ai)
#pragma unroll
                for (int m = 0; m < 4; ++m) {
                    const unsigned off = E1_OFF(ai, m, bj);
                    const f32x4 o0 = (acc[ai][bj][m][0] * rs[ai][m]) * ga + sha, o1 = (acc[ai][bj][m][1] * rs[ai][m]) * gb + shb;
                    if (E.fin) {
                        __builtin_nontemporal_store(o0, (f32x4*)((char*)E.out + off)); __builtin_nontemporal_store(o1, (f32x4*)((char*)E.out + off + 16));
                    } else {
                        u32x4 w; w.x = pk2(o0[0], o0[1]); w.y = pk2(o0[2], o0[3]); w.z = pk2(o1[0], o1[1]); w.w = pk2(o1[2], o1[3]);
                        *(u32x4*)((char*)E.hout + (off >> 1)) = w;
                    }
                }
        }
#undef E1_OFF
    } else if constexpr (emode == 2) {
        const int colh = u.pn * HALF + wc * 32 + 8 * fq;
#pragma unroll
        for (int ai = 0; ai < 2; ++ai)
#pragma unroll
            for (int m = 0; m < 4; ++m) {
                bf16_t* rowp = E.O + (size_t)(row0 + ai * HALF + m * 16) * FFH + colh;
                const f32x4 a0 = acc[ai][0][m][0], a1 = acc[ai][0][m][1], b0 = acc[ai][1][m][0], b1 = acc[ai][1][m][1];
                u32x4 w;
                w.x = pk2(silu_f(a0[0]) * b0[0], silu_f(a0[1]) * b0[1]); w.y = pk2(silu_f(a0[2]) * b0[2], silu_f(a0[3]) * b0[3]);
                w.z = pk2(silu_f(a1[0]) * b1[0], silu_f(a1[1]) * b1[1]); w.w = pk2(silu_f(a1[2]) * b1[2], silu_f(a1[3]) * b1[3]);
                __builtin_nontemporal_store(w, (u32x4*)rowp);
            }
    } else {
        if (u.pn < 12) {
            const int colt = u.pn * BM; const float sc = (colt >= 512 && colt < 1024) ? 0.08838834764831845f : 1.0f;
#pragma unroll
            for (int ai = 0; ai < 2; ++ai)
#pragma unroll
                for (int m = 0; m < 4; ++m) {
                    bf16_t* rowp = E.O + (size_t)(row0 + ai * HALF + m * 16) * NPROJ + colt + wc * 64 + 8 * fq;
#pragma unroll
                    for (int bj = 0; bj < 2; ++bj) {
                        const f32x4 v0 = acc[ai][bj][m][0] * sc, v1 = acc[ai][bj][m][1] * sc;
                        u32x4 w; w.x = pk2(v0[0], v0[1]); w.y = pk2(v0[2], v0[3]); w.z = pk2(v1[0], v1[1]); w.w = pk2(v1[2], v1[3]);
                        __builtin_nontemporal_store(w, (u32x4*)(rowp + bj * 32));
                    }
                }
        }
        if (u.pn == ((((u.pm >> 3) % 6)) & 3)) {
            const int r0 = u.pm * BM + (wr * 4 + wc) * 32;
            const bf16_t* Ap = E.A3 + (size_t)(r0 + fr) * D + fq * 8;
            const bf16_t* Bp = E.Wg + (size_t)fr * D + fq * 8;
            f32x4 g0 = {0.f, 0.f, 0.f, 0.f}, g1 = g0;
            for (int k0 = 0; k0 < 32; k0 += 8) {
                bf16x8 a0[8], a1[8], bq[8];
#pragma unroll
                for (int q = 0; q < 8; ++q) { a0[q] = *(const bf16x8*)(Ap + (k0 + q) * 32); a1[q] = *(const bf16x8*)(Ap + 16 * D + (k0 + q) * 32); bq[q] = *(const bf16x8*)(Bp + (k0 + q) * 32); }
#pragma unroll
                for (int q = 0; q < 8; ++q) { g0 = __builtin_amdgcn_mfma_f32_16x16x32_bf16(a0[q], bq[q], g0, 0, 0, 0); g1 = __builtin_amdgcn_mfma_f32_16x16x32_bf16(a1[q], bq[q], g1, 0, 0, 0); }
            }
            const float bgv = E.bg[fr];
#pragma unroll
            for (int i = 0; i < 4; ++i) {
                E.gates[(size_t)(r0 + 4 * fq + i) * 16 + fr] = g0[i] + bgv;
                E.gates[(size_t)(r0 + 16 + 4 * fq + i) * 16 + fr] = g1[i] + bgv;
            }
        }
    }
}

template <int MODE> DI void gemm_phase(LAS unsigned char* lds, const Gemm g, const StaticOrder& S, const Epi& E) {
    int tid_ = threadIdx.x; asm volatile("" : "+v"(tid_)); const int tid = tid_, wid = __builtin_amdgcn_readfirstlane(tid >> 6), lane = tid & 63, wr = wid >> 2, wc = wid & 3, fr = lane & 15, fq = lane >> 4;
    const int K = g.K, nt = K / BK, lda = g.lda;
    unsigned voffA[2], voffB[2];
#pragma unroll
    for (int i = 0; i < 2; ++i) { int R, C; stage_rc(tid * 16 + i * 8192, R, C);
        voffA[i] = (unsigned)(R * lda + C) * 2u; voffB[i] = (unsigned)((((R >> 5) * 64 + perm32(R & 31)) * K) + C) * 2u; }
    const size_t kstep = (size_t)(BK * 2);
    const size_t hstepA = (size_t)HALF * lda * 2, tstepA = 2 * hstepA;
    const size_t hstepB = (size_t)32 * K * 2, tstepB = (size_t)BM * K * 2;
    const unsigned ldsw = (unsigned)wid * 1024u;
    const int aoff = lds_byte(wr * 64 + fr, fq * 8), boff = lds_byte(wc * 32 + fr, fq * 8);
#define PG8_SA(b, h) (((b) * 2 + (h)) * HTB)
#define PG8_SB(b, h) ((4 + (b) * 2 + (h)) * HTB)
#define PG8_STAGE(bufoff, gbase, voff) do { _Pragma("unroll") for (int _i = 0; _i < 2; ++_i) \
        __builtin_amdgcn_global_load_lds((const unsigned*)((const char*)(gbase) + (voff)[_i]), (LAS unsigned*)(lds + (bufoff) + ldsw + _i * 8192), 16, 0, 0); } while (0)
#define PG8_LDA(dst, b, h) do { _Pragma("unroll") for (int m = 0; m < 4; ++m) _Pragma("unroll") for (int k = 0; k < 2; ++k) dst[m][k] = *(const LAS bf16x8*)(lds + PG8_SA(b, h) + aoff + m * 2048 + k * 1024); } while (0)
#define PG8_LDB(dst, b, h) do { _Pragma("unroll") for (int n = 0; n < 2; ++n) _Pragma("unroll") for (int k = 0; k < 2; ++k) dst[n][k] = *(const LAS bf16x8*)(lds + PG8_SB(b, h) + boff + n * 2048 + k * 1024); } while (0)
#define PG8_MMA(ai, bj, At, Bt) do { __builtin_amdgcn_s_setprio(1); _Pragma("unroll") for (int m = 0; m < 4; ++m) _Pragma("unroll") for (int n = 0; n < 2; ++n) _Pragma("unroll") for (int k = 0; k < 2; ++k) \
        acc[ai][bj][m][n] = __builtin_amdgcn_mfma_f32_16x16x32_bf16(Bt[n][k], At[m][k], acc[ai][bj][m][n], 0, 0, 0); __builtin_amdgcn_s_setprio(0); } while (0)
#define PG8_WAIT_V(n) asm volatile("s_waitcnt vmcnt(" #n ")" ::: "memory")
#define PG8_WAIT_L(n) asm volatile("s_waitcnt lgkmcnt(" #n ")" ::: "memory")
#define PG8_BAR __builtin_amdgcn_s_barrier()
#define PG8_SCHED __builtin_amdgcn_sched_barrier(0)
    Unit cur, nxt; int ui = 0;
    if (!S.next(0, cur)) return;
    f32x4 acc[2][2][4][2];
#pragma unroll
    for (int a = 0; a < 2; ++a)
#pragma unroll
        for (int b = 0; b < 2; ++b)
#pragma unroll
            for (int m = 0; m < 4; ++m)
#pragma unroll
                for (int n = 0; n < 2; ++n) acc[a][b][m][n] = (f32x4){0.f, 0.f, 0.f, 0.f};
    bf16x8 At[4][2], B0[2][2], B1[2][2];
    const char* cA = (const char*)g.A + (size_t)cur.pm * tstepA; const char* cB = (const char*)g.Bt + (size_t)cur.pn * tstepB;
    PG8_STAGE(PG8_SB(0, 0), cB, voffB); PG8_STAGE(PG8_SB(0, 1), cB + hstepB, voffB); PG8_STAGE(PG8_SA(0, 0), cA, voffA); PG8_STAGE(PG8_SA(0, 1), cA + hstepA, voffA);
    if (wr == 1) PG8_BAR;
    PG8_WAIT_V(2); PG8_BAR;
    PG8_STAGE(PG8_SB(1, 0), cB + kstep, voffB); PG8_STAGE(PG8_SA(1, 0), cA + kstep, voffA); PG8_STAGE(PG8_SB(1, 1), cB + hstepB + kstep, voffB);
    PG8_WAIT_V(6); PG8_BAR;
    for (;;) {
        const bool has_next = S.next(ui + 1, nxt);
        const char* nA = has_next ? (const char*)g.A + (size_t)nxt.pm * tstepA : cA; const char* nB = has_next ? (const char*)g.Bt + (size_t)nxt.pn * tstepB : cB;
        for (int t = 0; t < nt; t += 2) {
            const bool last = (t == nt - 2);
            const char* a1 = cA + (size_t)(t + 1) * kstep;
            const char* a2 = last ? nA : cA + (size_t)(t + 2) * kstep; const char* b2 = last ? nB : cB + (size_t)(t + 2) * kstep;
            const char* a3 = a2 + kstep; const char* b3 = b2 + kstep;
            PG8_LDB(B0, 0, 0); PG8_LDB(B1, 0, 1); PG8_SCHED; PG8_LDA(At, 0, 0); PG8_STAGE(PG8_SA(1, 1), a1 + hstepA, voffA);
            PG8_WAIT_V(8); PG8_WAIT_L(0); PG8_BAR; PG8_MMA(0, 0, At, B0); PG8_MMA(0, 1, At, B1); PG8_BAR; PG8_SCHED;
            PG8_LDA(At, 0, 1); PG8_STAGE(PG8_SB(0, 0), b2, voffB); PG8_STAGE(PG8_SB(0, 1), b2 + hstepB, voffB); PG8_STAGE(PG8_SA(0, 0), a2, voffA);
            PG8_WAIT_V(8); PG8_WAIT_L(0); PG8_BAR; PG8_MMA(1, 0, At, B0); PG8_MMA(1, 1, At, B1); PG8_BAR; PG8_SCHED;
            PG8_LDB(B0, 1, 0); PG8_LDB(B1, 1, 1); PG8_SCHED; PG8_LDA(At, 1, 0); PG8_STAGE(PG8_SA(0, 1), a2 + hstepA, voffA);
            PG8_WAIT_V(8); PG8_WAIT_L(0); PG8_BAR; PG8_MMA(0, 0, At, B0); PG8_MMA(0, 1, At, B1); PG8_BAR; PG8_SCHED;
            PG8_LDA(At, 1, 1); PG8_STAGE(PG8_SB(1, 0), b3, voffB); PG8_STAGE(PG8_SB(1, 1), b3 + hstepB, voffB); PG8_STAGE(PG8_SA(1, 0), a3, voffA);
            PG8_WAIT_V(8); PG8_WAIT_L(0); PG8_BAR; PG8_MMA(1, 0, At, B0); PG8_MMA(1, 1, At, B1); PG8_BAR; PG8_SCHED;
        }
        if (wr == 0) PG8_BAR;
        epilogue<MODE>(E, acc, cur, wr, wc, fr, fq);
        if (!has_next) break;
#pragma unroll
        for (int a = 0; a < 2; ++a)
#pragma unroll
            for (int b = 0; b < 2; ++b)
#pragma unroll
                for (int m = 0; m < 4; ++m)
#pragma unroll
                    for (int n = 0; n < 2; ++n) acc[a][b][m][n] = (f32x4){0.f, 0.f, 0.f, 0.f};
        cur = nxt; cA = nA; cB = nB; ++ui;
        if (wr == 1) PG8_BAR;
    }
    PG8_WAIT_V(0);
    PG8_BAR;
#undef PG8_SA
#undef PG8_SB
#undef PG8_STAGE
#undef PG8_LDA
#undef PG8_LDB
#undef PG8_MMA
#undef PG8_WAIT_V
#undef PG8_WAIT_L
#undef PG8_BAR
#undef PG8_SCHED
}
}

DI void transpose_item(const float* W, int K, int N, int ncols, bf16_t* WT, int gu, LAS float* scr, int item, int lane) {
    const int nblk = ncols / 32, kb = item / nblk, nb = item % nblk, k0 = 64 * kb, n0 = 32 * nb;
#pragma unroll 8
    for (int i = 0; i < 32; ++i) { const int kk = 2 * i + (lane >> 5); scr[kk * 33 + (lane & 31)] = W[(size_t)(k0 + kk) * N + n0 + (lane & 31)]; }
    asm volatile("s_waitcnt lgkmcnt(0)" ::: "memory");
    int r0 = n0;
    if (gu) { const int nn = (n0 < FFH) ? n0 : n0 - FFH; r0 = 256 * (nn >> 7) + 64 * ((nn & 127) >> 5) + ((n0 < FFH) ? 0 : 32); }
    const int c = lane & 7;
#pragma unroll
    for (int j = 0; j < 4; ++j) { const int n = (lane >> 3) + 8 * j; const LAS float* s = scr + (8 * c) * 33 + n;
        u32x4 o; o.x = pk2(s[0 * 33], s[1 * 33]); o.y = pk2(s[2 * 33], s[3 * 33]); o.z = pk2(s[4 * 33], s[5 * 33]); o.w = pk2(s[6 * 33], s[7 * 33]);
        *(u32x4*)(WT + (size_t)(r0 + n) * K + k0 + 8 * c) = o; }
    asm volatile("s_waitcnt lgkmcnt(0)" ::: "memory");
}

DI void sincos_d(double x, float& s, float& c) {
    const double q = __builtin_rint(x * 0.63661977236758134308);
    const double r = (x - q * 1.57079632679489655800) - q * 6.12323399573676603587e-17;
    const double r2 = r * r;
    double sp = 1.0 / 6227020800.0; sp = sp * r2 - 1.0 / 39916800.0; sp = sp * r2 + 1.0 / 362880.0; sp = sp * r2 - 1.0 / 5040.0; sp = sp * r2 + 1.0 / 120.0; sp = sp * r2 - 1.0 / 6.0; sp = sp * r2 + 1.0; sp *= r;
    double cp = -1.0 / 87178291200.0; cp = cp * r2 + 1.0 / 479001600.0; cp = cp * r2 - 1.0 / 3628800.0; cp = cp * r2 + 1.0 / 40320.0; cp = cp * r2 - 1.0 / 720.0; cp = cp * r2 + 1.0 / 24.0; cp = cp * r2 - 0.5; cp = cp * r2 + 1.0;
    const int qi = ((int)q) & 3;
    const double ss = (qi == 0) ? sp : (qi == 1) ? cp : (qi == 2) ? -sp : -cp;
    const double cc = (qi == 0) ? cp : (qi == 1) ? -sp : (qi == 2) ? -cp : sp;
    s = (float)ss; c = (float)cc;
}

struct Args { const float* in[23]; float* out; unsigned char* ws; };

DI void prologue(LAS unsigned char* lds, const Args& a, int G, int bid) {
    int tid_ = threadIdx.x; asm volatile("" : "+v"(tid_)); asm volatile("" : "+s"(bid)); const int tid = tid_, wid = __builtin_amdgcn_readfirstlane(tid >> 6), lane = tid & 63;
    LAS float* scr = (LAS float*)(lds + wid * 16384);
    unsigned char* ws = a.ws;
    const int gw = bid * 8 + wid, NGW = G * 8;
    constexpr int I_QKV = 16 * (NQKV / 32), I_WO = 8 * (D / 32), I_GU = 16 * (NGU / 32), I_DN = (FFH / 64) * (D / 32), I_IN = 16 * (NPROJ / 32), I_OUT = 16 * (D / 32);
    constexpr int NITEMS = I_QKV + I_WO + 2 * I_GU + 2 * I_DN + I_IN + I_OUT;
    for (int it = gw; it < NITEMS; it += NGW) {
        int r = it;
        if (r < I_QKV) { transpose_item(a.in[7], D, NQKV, NQKV, (bf16_t*)(ws + WS_WQKV), 0, scr, r, lane); continue; } r -= I_QKV;
        if (r < I_WO) { transpose_item(a.in[8], 512, D, D, (bf16_t*)(ws + WS_WO), 0, scr, r, lane); continue; } r -= I_WO;
        if (r < I_GU) { transpose_item(a.in[10], D, NGU, NGU, (bf16_t*)(ws + WS_WGU0), 1, scr, r, lane); continue; } r -= I_GU;
        if (r < I_DN) { transpose_item(a.in[11], FFH, D, D, (bf16_t*)(ws + WS_WDN0), 0, scr, r, lane); continue; } r -= I_DN;
        if (r < I_IN) { transpose_item(a.in[15], D, NIN, NPROJ, (bf16_t*)(ws + WS_WIN), 0, scr, r, lane); continue; } r -= I_IN;
        if (r < I_OUT) { transpose_item(a.in[18], D, D, D, (bf16_t*)(ws + WS_WOUT), 0, scr, r, lane); continue; } r -= I_OUT;
        if (r < I_GU) { transpose_item(a.in[20], D, NGU, NGU, (bf16_t*)(ws + WS_WGU1), 1, scr, r, lane); continue; } r -= I_GU;
        transpose_item(a.in[21], FFH, D, D, (bf16_t*)(ws + WS_WDN1), 0, scr, r, lane);
    }
    {
        bf16_t* wt = (bf16_t*)(ws + WS_WIN); const float* W = a.in[15];
        for (int e = bid * 512 + tid; e < 256 * D; e += G * 512) {
            const int rr = e >> 10, k = e & 1023; const int n = NPROJ + rr;
            float v = 0.f; if (n < NIN) v = W[(size_t)k * NIN + n];
            wt[(size_t)n * D + k] = (bf16_t)(pk2(v, 0.f) & 0xffffu);
        }
    }
    {
        float* rope = (float*)(ws + WS_ROPE);
        for (int e = bid * 512 + tid; e < 8192 * 8; e += G * 512) {
            const int pos = e >> 3, i = e & 7;
            const float inv = exp2f(-(float)i * 0.125f * 18.931568569324174f);
            const float ang = (float)pos * inv;
            float s, c; sincos_d((double)ang, s, c);
            rope[pos * 16 + i] = c; rope[pos * 16 + 8 + i] = s;
        }
    }
    {
        float* mod = (float*)(ws + WS_MOD);
        for (int it = gw; it < 2 * 96 * 16; it += NGW) {
            const int ks = it & 15, cb = (it >> 4) % 96, layer = it / (96 * 16);
            const float* W = a.in[layer ? 12 : 4]; const float* bias = a.in[layer ? 13 : 5];
            const int n = cb * 64 + lane, k0 = ks * 64;
#pragma unroll
            for (int b = 0; b < 16; ++b) {
                const float cv = (b < 8) ? a.in[2][b * D + k0 + lane] : a.in[3][(b - 8) * D + k0 + lane];
                scr[b * 64 + lane] = cv / (1.0f + __expf(-cv));
            }
            asm volatile("s_waitcnt lgkmcnt(0)" ::: "memory");
            float accm[16];
#pragma unroll
            for (int b = 0; b < 16; ++b) accm[b] = 0.f;
            for (int kk = 0; kk < 64; ++kk) {
                const float w = W[(size_t)(k0 + kk) * 6144 + n];
#pragma unroll
                for (int b = 0; b < 16; ++b) accm[b] += scr[b * 64 + kk] * w;
            }
            const float bv = (ks == 0) ? bias[n] : 0.f;
#pragma unroll
            for (int b = 0; b < 16; ++b) atomicAdd(mod + ((size_t)layer * 16 + b) * 6144 + n, accm[b] + bv);
            asm volatile("s_waitcnt lgkmcnt(0)" ::: "memory");
        }
    }
}

DI void normmod_phase(const float* xp, const float* xs, const float* g, const float* sh, const float* sc, bf16_t* out, int G, int bid) {
    int tid_ = threadIdx.x; asm volatile("" : "+v"(tid_)); asm volatile("" : "+s"(bid)); const int tid = tid_, wid = tid >> 6, lane = tid & 63;
    const int gw = bid * 8 + wid, NGW = G * 8;
    f32x4 v[4], u[4];
    int row = gw;
    if (row < T) { const float* src = (row < TP ? xp : xs) + (size_t)row * D;
#pragma unroll
        for (int j = 0; j < 4; ++j) v[j] = __builtin_nontemporal_load(((const f32x4*)src) + 64 * j + lane); }
    while (row < T) {
        const int nrow = row + NGW;
        if (nrow < T) { const float* src = (nrow < TP ? xp : xs) + (size_t)nrow * D;
#pragma unroll
            for (int j = 0; j < 4; ++j) u[j] = __builtin_nontemporal_load(((const f32x4*)src) + 64 * j + lane); }
        float ss = 0.f;
#pragma unroll
        for (int j = 0; j < 4; ++j) ss += (v[j].x * v[j].x + v[j].y * v[j].y) + (v[j].z * v[j].z + v[j].w * v[j].w);
        const float rstd = rsqrtf(wave_sum(ss) * (1.0f / D) + RMS_EPS);
        const int bidx = batch_of_row(row);
#pragma unroll
        for (int j = 0; j < 4; ++j) {
            const int c = 256 * j + 4 * lane;
            const f32x4 g4 = *(const f32x4*)(g + c), sc4 = *(const f32x4*)(sc + bidx * 6144 + c), sh4 = *(const f32x4*)(sh + bidx * 6144 + c);
            const f32x4 o = (v[j] * rstd) * g4 * (sc4 + 1.0f) + sh4;
            u32x2 w; w.x = pk2(o.x, o.y); w.y = pk2(o.z, o.w);
            *(u32x2*)(out + (size_t)row * D + c) = w;
        }
#pragma unroll
        for (int j = 0; j < 4; ++j) v[j] = u[j];
        row = nrow;
    }
}
DI void finalnorm_phase(float* x, const float* g, int G, int bid) {
    int tid_ = threadIdx.x; asm volatile("" : "+v"(tid_)); asm volatile("" : "+s"(bid)); const int tid = tid_, wid = tid >> 6, lane = tid & 63;
    const int gw = bid * 8 + wid, NGW = G * 8;
    for (int row = gw; row < T; row += NGW) {
        float* src = x + (size_t)row * D;
        f32x4 v[4]; float ss = 0.f;
#pragma unroll
        for (int j = 0; j < 4; ++j) { v[j] = ((const f32x4*)src)[64 * j + lane]; ss += (v[j].x * v[j].x + v[j].y * v[j].y) + (v[j].z * v[j].z + v[j].w * v[j].w); }
        const float rstd = rsqrtf(wave_sum(ss) * (1.0f / D) + RMS_EPS);
#pragma unroll
        for (int j = 0; j < 4; ++j) { const f32x4 g4 = *(const f32x4*)(g + 256 * j + 4 * lane); ((f32x4*)src)[64 * j + lane] = (v[j] * rstd) * g4; }
    }
}

constexpr int AK_STRIDE = 144, AV_STRIDE = 160, AK_BYTES = 384 * AK_STRIDE;
struct AttnUnit { int tok0, dsh, p, l0, L, g, h; };
DI AttnUnit attn_decode(int u) {
    AttnUnit a; a.h = u & 7; a.g = (u >> 3) % 3; const int tt = u / 24;
    int sg, S;
    if (tt < 256) { a.tok0 = (tt >> 5) * 8192; sg = tt & 31; S = 8192; } else { const int t2 = tt - 256; a.tok0 = TP + (t2 >> 4) * 4096; sg = t2 & 15; S = 4096; }
    a.dsh = 2 * a.g; a.L = S >> a.dsh; const int spp = a.L >> 8; a.p = sg / spp; a.l0 = (sg % spp) * 256;
    return a;
}
DI void attn_phase(LAS unsigned char* lds, bf16_t* QKV, float* lse, int G, int bid) {
    int tid_ = threadIdx.x; asm volatile("" : "+v"(tid_)); asm volatile("" : "+s"(bid)); const int tid = tid_, wid = __builtin_amdgcn_readfirstlane(tid >> 6), lane = tid & 63, fr = lane & 15, fq = lane >> 4;
    LAS unsigned char* Ks = lds; LAS unsigned char* Vs = lds + AK_BYTES;
    const int NU = (T / 256) * 24;
    const int bi = wid >> 1, half = wid & 1;
    u32x4 pk_[6], pv_[6]; bf16x8 pq_[2][2];
    if (bid < NU) {
        const AttnUnit a = attn_decode(bid);
        const bf16_t* qb = QKV + (size_t)((a.g * 3) * 8 + a.h) * T * 64; const bf16_t* kb = qb + (size_t)8 * T * 64; const bf16_t* vb = kb + (size_t)8 * T * 64;
#pragma unroll
        for (int ps = 0; ps < 6; ++ps) { const int rr = ps * 64 + (tid >> 3), ch = tid & 7, l = a.l0 - 64 + rr;
            u32x4 kv = {0u, 0u, 0u, 0u}, vv = kv;
            if (l >= 0 && l < a.L) { const size_t tok = (size_t)a.tok0 + ((size_t)l << a.dsh) + a.p; kv = *(const u32x4*)(kb + tok * 64 + ch * 8); vv = *(const u32x4*)(vb + tok * 64 + ch * 8); }
            pk_[ps] = kv; pv_[ps] = vv; }
#pragma unroll
        for (int qt = 0; qt < 2; ++qt) { const int l = a.l0 + 64 * bi + 32 * half + 16 * qt + fr; const size_t tok = (size_t)a.tok0 + ((size_t)l << a.dsh) + a.p;
#pragma unroll
            for (int ks = 0; ks < 2; ++ks) pq_[qt][ks] = *(const bf16x8*)(qb + tok * 64 + ks * 32 + fq * 8); }
    }
    for (int u = bid; u < NU; u += G) {
        const AttnUnit a = attn_decode(u);
        LBAR();
#pragma unroll
        for (int ps = 0; ps < 6; ++ps) { const int rr = ps * 64 + (tid >> 3), ch = tid & 7;
            *(LAS u32x4*)(Ks + rr * AK_STRIDE + ch * 16) = pk_[ps]; *(LAS u32x4*)(Vs + rr * AV_STRIDE + ch * 16) = pv_[ps]; }
        bf16x8 qf[2][2];
#pragma unroll
        for (int qt = 0; qt < 2; ++qt)
#pragma unroll
            for (int ks = 0; ks < 2; ++ks) qf[qt][ks] = pq_[qt][ks];
        if (u + G < NU) {
            const AttnUnit b = attn_decode(u + G);
            const bf16_t* qb = QKV + (size_t)((b.g * 3) * 8 + b.h) * T * 64; const bf16_t* kb = qb + (size_t)8 * T * 64; const bf16_t* vb = kb + (size_t)8 * T * 64;
#pragma unroll
            for (int ps = 0; ps < 6; ++ps) { const int rr = ps * 64 + (tid >> 3), ch = tid & 7, l = b.l0 - 64 + rr;
                u32x4 kv = {0u, 0u, 0u, 0u}, vv = kv;
                if (l >= 0 && l < b.L) { const size_t tok = (size_t)b.tok0 + ((size_t)l << b.dsh) + b.p; kv = *(const u32x4*)(kb + tok * 64 + ch * 8); vv = *(const u32x4*)(vb + tok * 64 + ch * 8); }
                pk_[ps] = kv; pv_[ps] = vv; }
#pragma unroll
            for (int qt = 0; qt < 2; ++qt) { const int l = b.l0 + 64 * bi + 32 * half + 16 * qt + fr; const size_t tok = (size_t)b.tok0 + ((size_t)l << b.dsh) + b.p;
#pragma unroll
                for (int ks = 0; ks < 2; ++ks) pq_[qt][ks] = *(const bf16x8*)(qb + tok * 64 + ks * 32 + fq * 8); }
        }
        LBAR();
        f32x4 sacc[10][2];
#pragma unroll
        for (int jt = 0; jt < 10; ++jt) { sacc[jt][0] = (f32x4){0.f, 0.f, 0.f, 0.f}; sacc[jt][1] = sacc[jt][0]; }
        const int krow0 = 64 * bi + 32 * half;
#pragma unroll
        for (int jb = 0; jb < 5; ++jb) {
            bf16x8 kf[2][2];
#pragma unroll
            for (int j5 = 0; j5 < 2; ++j5)
#pragma unroll
                for (int ks = 0; ks < 2; ++ks) kf[j5][ks] = *(const LAS bf16x8*)(Ks + (krow0 + 16 * (2 * jb + j5) + fr) * AK_STRIDE + ks * 64 + fq * 16);
            __builtin_amdgcn_sched_barrier(0);
#pragma unroll
            for (int ks = 0; ks < 2; ++ks)
#pragma unroll
                for (int j5 = 0; j5 < 2; ++j5) {
                    if (2 * jb + j5 <= 8) sacc[2 * jb + j5][0] = __builtin_amdgcn_mfma_f32_16x16x32_bf16(kf[j5][ks], qf[0][ks], sacc[2 * jb + j5][0], 0, 0, 0);
                    if (2 * jb + j5 >= 1) sacc[2 * jb + j5][1] = __builtin_amdgcn_mfma_f32_16x16x32_bf16(kf[j5][ks], qf[1][ks], sacc[2 * jb + j5][1], 0, 0, 0);
                }
            __builtin_amdgcn_sched_barrier(0);
        }
        const float SC = 0.125f * 1.4426950408889634f;
        float mx[2], den[2];
        const int lkb = a.l0 + 64 * bi - 64 + 32 * half;
        const bool edge = (lkb < 0) || (lkb + 160 > a.L);
#pragma unroll
        for (int qt = 0; qt < 2; ++qt) {
            float m = -1e30f;
#pragma unroll
            for (int jt = 0; jt < 10; ++jt) {
                const int dj = jt - qt;
                if (dj < 0 || dj > 8) continue;
#pragma unroll
                for (int i = 0; i < 4; ++i) {
                    float sv = sacc[jt][qt][i];
                    if (dj == 0) sv = (4 * fq + i >= fr) ? sv : -1e30f;
                    if (dj == 8) sv = (4 * fq + i <= fr) ? sv : -1e30f;
                    if (edge) { const int lk = lkb + 16 * jt + 4 * fq + i; sv = (lk >= 0 && lk < a.L) ? sv : -1e30f; }
                    sacc[jt][qt][i] = sv; m = fmaxf(m, sv);
                }
            }
            m = fmaxf(m, __shfl_xor(m, 16)); m = fmaxf(m, __shfl_xor(m, 32));
            m *= SC;
            float d = 0.f;
#pragma unroll
            for (int jt = 0; jt < 10; ++jt) {
                const int dj = jt - qt;
                if (dj < 0 || dj > 8) { sacc[jt][qt] = (f32x4){0.f, 0.f, 0.f, 0.f}; continue; }
#pragma unroll
                for (int i = 0; i < 4; ++i) { const float p = __builtin_amdgcn_exp2f(__builtin_fmaf(sacc[jt][qt][i], SC, -m)); sacc[jt][qt][i] = p; d += p; }
            }
            d += __shfl_xor(d, 16); d += __shfl_xor(d, 32);
            mx[qt] = m; den[qt] = d;
        }
        f32x4 oacc[4][2];
#pragma unroll
        for (int dt = 0; dt < 4; ++dt) { oacc[dt][0] = (f32x4){0.f, 0.f, 0.f, 0.f}; oacc[dt][1] = oacc[dt][0]; }
#pragma unroll
        for (int jj = 0; jj < 5; ++jj) {
            bf16x8 pb[2];
#pragma unroll
            for (int qt = 0; qt < 2; ++qt) {
                u32x4 w; w.x = pk2(sacc[2 * jj][qt][0], sacc[2 * jj][qt][1]); w.y = pk2(sacc[2 * jj][qt][2], sacc[2 * jj][qt][3]);
                w.z = pk2(sacc[2 * jj + 1][qt][0], sacc[2 * jj + 1][qt][1]); w.w = pk2(sacc[2 * jj + 1][qt][2], sacc[2 * jj + 1][qt][3]);
                pb[qt] = __builtin_bit_cast(bf16x8, w);
            }
            const int vr = krow0 + 32 * jj + 4 * fq + (fr >> 2);
            bf16x8 vf[4];
#pragma unroll
            for (int dt = 0; dt < 4; ++dt) {
                const s16x4 lo = __builtin_bit_cast(s16x4, __builtin_amdgcn_ds_read_tr16_b64_v4i16((LAS v4i16_t*)(Vs + vr * AV_STRIDE + (16 * dt + 4 * (fr & 3)) * 2)));
                const s16x4 hi = __builtin_bit_cast(s16x4, __builtin_amdgcn_ds_read_tr16_b64_v4i16((LAS v4i16_t*)(Vs + (vr + 16) * AV_STRIDE + (16 * dt + 4 * (fr & 3)) * 2)));
                vf[dt] = (bf16x8){lo[0], lo[1], lo[2], lo[3], hi[0], hi[1], hi[2], hi[3]};
            }
            __builtin_amdgcn_sched_barrier(0);
#pragma unroll
            for (int dt = 0; dt < 4; ++dt) {
                oacc[dt][0] = __builtin_amdgcn_mfma_f32_16x16x32_bf16(vf[dt], pb[0], oacc[dt][0], 0, 0, 0);
                oacc[dt][1] = __builtin_amdgcn_mfma_f32_16x16x32_bf16(vf[dt], pb[1], oacc[dt][1], 0, 0, 0);
            }
            __builtin_amdgcn_sched_barrier(0);
        }
#pragma unroll
        for (int qt = 0; qt < 2; ++qt) {
            const int l = a.l0 + 64 * bi + 32 * half + 16 * qt + fr; const size_t tok = (size_t)a.tok0 + ((size_t)l << a.dsh) + a.p;
            const float inv = 1.0f / den[qt];
            bf16_t* op = QKV + ((size_t)((a.g * 3) * 8 + a.h) * T + tok) * 64 + 4 * fq;
            u32x2 w[4];
#pragma unroll
            for (int dt = 0; dt < 4; ++dt) { w[dt].x = pk2(oacc[dt][qt][0] * inv, oacc[dt][qt][1] * inv); w[dt].y = pk2(oacc[dt][qt][2] * inv, oacc[dt][qt][3] * inv); }
            { const bool odd = (fq & 1) != 0;
              const u32x2 s01 = odd ? w[0] : w[1], s23 = odd ? w[2] : w[3];
              u32x2 r01, r23; r01.x = __shfl_xor(s01.x, 16); r01.y = __shfl_xor(s01.y, 16); r23.x = __shfl_xor(s23.x, 16); r23.y = __shfl_xor(s23.y, 16);
              const u32x4 o0 = odd ? (u32x4){r01.x, r01.y, w[1].x, w[1].y} : (u32x4){w[0].x, w[0].y, r01.x, r01.y};
              const u32x4 o1 = odd ? (u32x4){r23.x, r23.y, w[3].x, w[3].y} : (u32x4){w[2].x, w[2].y, r23.x, r23.y};
              bf16_t* ob = op - 4 * fq + 8 * (fq >> 1) + (odd ? 16 : 0);
              __builtin_nontemporal_store(o0, (u32x4*)ob); __builtin_nontemporal_store(o1, (u32x4*)(ob + 32)); }
            if (fq == 0) lse[tok * 24 + a.g * 8 + a.h] = (mx[qt] + __builtin_amdgcn_logf(den[qt])) * 0.6931471805599453f;
        }
    }
    LBAR();
}

DI void attn_combine_phase(const bf16_t* QKV, const float* lse, bf16_t* Y, int G, int bid) {
    int tid_ = threadIdx.x; asm volatile("" : "+v"(tid_)); asm volatile("" : "+s"(bid)); const int tid = tid_, wid = tid >> 6, lane = tid & 63;
    const int gw = bid * 8 + wid, NGW = G * 8;
    const int ts = lane >> 3, ch = lane & 7;
    for (int t8 = gw; t8 < T / 8; t8 += NGW) {
        const size_t tok = (size_t)t8 * 8 + ts;
        const float* lp = lse + tok * 24;
#pragma unroll 2
        for (int h = 0; h < 8; ++h) {
            const u32x4 o0 = __builtin_nontemporal_load((const u32x4*)(QKV + ((size_t)(0 * 8 + h) * T + tok) * 64 + ch * 8));
            const u32x4 o1 = __builtin_nontemporal_load((const u32x4*)(QKV + ((size_t)(3 * 8 + h) * T + tok) * 64 + ch * 8));
            const u32x4 o2 = __builtin_nontemporal_load((const u32x4*)(QKV + ((size_t)(6 * 8 + h) * T + tok) * 64 + ch * 8));
            const float l0 = lp[h], l1 = lp[8 + h], l2 = lp[16 + h];
            const float m = fmaxf(l0, fmaxf(l1, l2));
            float e0 = __expf(l0 - m), e1 = __expf(l1 - m), e2 = __expf(l2 - m);
            const float inv = 1.0f / (e0 + e1 + e2); e0 *= inv; e1 *= inv; e2 *= inv;
            u32x4 w;
#pragma unroll
            for (int i = 0; i < 4; ++i) {
                const float lo = e0 * bflo(o0[i]) + e1 * bflo(o1[i]) + e2 * bflo(o2[i]);
                const float hi = e0 * bfhi(o0[i]) + e1 * bfhi(o1[i]) + e2 * bfhi(o2[i]);
                w[i] = pk2(lo, hi);
            }
            *(u32x4*)(Y + tok * 512 + h * 64 + ch * 8) = w;
        }
    }
}

constexpr int MQ_STRIDE = 272, MV_STRIDE = 160;
constexpr int M_QS = 0, M_KS = 34816, M_VS = 69632, M_VWS = 90112, M_CS = 110592, M_SM = 132352;
DI float logsig(float x) { return fminf(x, 0.f) - log1pf(__expf(-fabsf(x))); }
DI bf16x8 tr_pair(const LAS unsigned char* p0, const LAS unsigned char* p1) {
    const s16x4 lo = __builtin_bit_cast(s16x4, __builtin_amdgcn_ds_read_tr16_b64_v4i16((LAS v4i16_t*)p0));
    const s16x4 hi = __builtin_bit_cast(s16x4, __builtin_amdgcn_ds_read_tr16_b64_v4i16((LAS v4i16_t*)p1));
    return (bf16x8){lo[0], lo[1], lo[2], lo[3], hi[0], hi[1], hi[2], hi[3]};
}
DI void mlstm_phase(LAS unsigned char* lds, const bf16_t* proj, const float* gates, bf16_t* Hfw, bf16_t* Hbw, int G, int bid) {
    int tid_ = threadIdx.x; asm volatile("" : "+v"(tid_)); asm volatile("" : "+s"(bid)); const int tid = tid_, wid = __builtin_amdgcn_readfirstlane(tid >> 6), lane = tid & 63, fr = lane & 15, fq = lane >> 4;
    LAS unsigned char* Qs = lds + M_QS; LAS unsigned char* Ks = lds + M_KS; LAS unsigned char* Vs = lds + M_VS; LAS unsigned char* VWs = lds + M_VWS; LAS unsigned char* Cs = lds + M_CS;
    LAS float* smal = (LAS float*)(lds + M_SM);
    for (int item = bid; item < 512; item += G) {
        const int it_ = item & 255; const bool lng = item < 256;
        const int it = ((((it_ >> 3) >> 2) * 8 + (it_ & 7)) << 2) | ((it_ >> 3) & 3);
        const int sl = it & 3, dir = (it >> 2) & 1, hh = (it >> 3) & 3, b = it >> 5;
        const int S = lng ? 8192 : 4096; const int tok0 = lng ? b * 8192 : TP + b * 4096; const int nc = S >> 7;
        bf16_t* Hout = dir ? Hbw : Hfw;
        const int gcol = dir * 8 + hh;
        LBAR();
        for (int i = tid; i < 80 * MQ_STRIDE / 4; i += 512) ((LAS unsigned*)Cs)[i] = 0u;
        if (tid < 128) { LAS unsigned* p = (LAS unsigned*)(Vs + tid * MV_STRIDE + 128); unsigned z = 0u; asm volatile("" : "+v"(z)); p[0] = 0x3F80u | z;
#pragma unroll
            for (int i = 1; i < 8; ++i) p[i] = z; }
        const int nown = (wid < 2) ? 2 : ((wid < 6) ? 1 : 0);
        f32x4 Creg[2][5];
#pragma unroll
        for (int dt = 0; dt < 5; ++dt) { Creg[0][dt] = (f32x4){0.f, 0.f, 0.f, 0.f}; Creg[1][dt] = Creg[0][dt]; }
        float mprev = 0.f;
        u32x4 pq[4], pk[4], pv[2]; float gi0 = 0.f, gi1 = 0.f, gf0 = 0.f, gf1 = 0.f;
#define MTOK(tau) ((size_t)tok0 + (size_t)(dir ? (S - 1 - (tau)) : (tau)))
#define MLOAD(c) do { \
            _Pragma("unroll") for (int i = 0; i < 4; ++i) { const int ci = tid + 512 * i, row = ci >> 4, ch = ci & 15; const bf16_t* rp = proj + MTOK((c) * 128 + row) * NPROJ; \
                pq[i] = *(const u32x4*)(rp + hh * 128 + ch * 8); pk[i] = *(const u32x4*)(rp + 512 + hh * 128 + ch * 8); } \
            _Pragma("unroll") for (int i = 0; i < 2; ++i) { const int ci = tid + 512 * i, row = ci >> 3, ch = ci & 7; const bf16_t* rp = proj + MTOK((c) * 128 + row) * NPROJ; \
                pv[i] = *(const u32x4*)(rp + 1024 + hh * 256 + sl * 64 + ch * 8); } } while (0)
#define GLOAD(c) do { const float* g0 = gates + MTOK((c) * 128 + 2 * lane) * 16; const float* g1 = gates + MTOK((c) * 128 + 2 * lane + 1) * 16; \
                gi0 = g0[gcol]; gf0 = g0[gcol + 4]; gi1 = g1[gcol]; gf1 = g1[gcol + 4]; } while (0)
#define GATES(bufi) do { LAS float* sa_ = smal + (bufi) * 388; LAS float* sM_ = sa_ + 128; LAS float* sb_ = sa_ + 256; LAS float* scl_ = sa_ + 384; \
                const float lf0 = logsig(gf0), lf1 = logsig(gf1); const float ps = lf0 + lf1; float inc = ps; \
                _Pragma("unroll") for (int o = 1; o < 64; o <<= 1) { const float t = __shfl_up(inc, o); if (lane >= o) inc += t; } \
                const float b0 = inc - ps + lf0, b1 = inc; const float a0 = gi0 - b0, a1 = gi1 - b1; float imx = fmaxf(a0, a1); \
                _Pragma("unroll") for (int o = 1; o < 64; o <<= 1) { const float t = __shfl_up(imx, o); if (lane >= o) imx = fmaxf(imx, t); } \
                float exm = __shfl_up(imx, 1); if (lane == 0) exm = -1e30f; \
                const float M0 = fmaxf(mprev, fmaxf(exm, a0)), M1 = fmaxf(mprev, imx); \
                sa_[2 * lane] = a0; sa_[2 * lane + 1] = a1; sM_[2 * lane] = M0; sM_[2 * lane + 1] = M1; sb_[2 * lane] = b0; sb_[2 * lane + 1] = b1; \
                const float M127_ = __shfl(M1, 63), b127_ = __shfl(b1, 63); \
                if (lane == 0) { scl_[0] = mprev; scl_[1] = M127_; } \
                mprev = b127_ + M127_; } while (0)
        MLOAD(0);
        if (wid == 2) { GLOAD(0); GATES(0); }
        LBAR();
        for (int c = 0; c < nc; ++c) {
            const int cur = c & 1;
            LAS float* sa = smal + cur * 388; LAS float* sM = sa + 128; LAS float* sb = sa + 256; LAS float* scl = sa + 384;
            const float mp = scl[0], M127 = scl[1];
#pragma unroll
            for (int i = 0; i < 4; ++i) { const int ci = tid + 512 * i, row = ci >> 4, ch = ci & 15;
                *(LAS u32x4*)(Qs + row * MQ_STRIDE + ch * 16) = pq[i]; *(LAS u32x4*)(Ks + row * MQ_STRIDE + ch * 16) = pk[i]; }
#pragma unroll
            for (int i = 0; i < 2; ++i) { const int ci = tid + 512 * i, row = ci >> 3, ch = ci & 7;
                *(LAS u32x4*)(Vs + row * MV_STRIDE + ch * 16) = pv[i];
                const float wsv = __expf(sa[row] - M127);
                u32x4 w;
#pragma unroll
                for (int e = 0; e < 4; ++e) w[e] = pk2(bflo(pv[i][e]) * wsv, bfhi(pv[i][e]) * wsv);
                *(LAS u32x4*)(VWs + row * MV_STRIDE + ch * 16) = w;
                if (ch == 0) { const u32x4 x0 = {pk2(wsv, 0.f), 0u, 0u, 0u}, x1 = {0u, 0u, 0u, 0u};
                    *(LAS u32x4*)(VWs + row * MV_STRIDE + 128) = x0; *(LAS u32x4*)(VWs + row * MV_STRIDE + 144) = x1; }
            }
            if (c + 1 < nc) { MLOAD(c + 1); if (wid == 2) GLOAD(c + 1); }
            LBAR();
            {
                const int t = 16 * wid + fr;
                bf16x8 qf[4];
#pragma unroll
                for (int ks = 0; ks < 4; ++ks) qf[ks] = *(const LAS bf16x8*)(Qs + t * MQ_STRIDE + ks * 64 + fq * 16);
                const float Mt = sM[t], bt = sb[t];
                f32x4 nacc[5];
                {
                    bf16x8 cf[2][4];
#pragma unroll
                    for (int dt = 0; dt < 5; ++dt) nacc[dt] = (f32x4){0.f, 0.f, 0.f, 0.f};
#pragma unroll
                    for (int db = 0; db < 3; ++db) {
#pragma unroll
                        for (int dt = 0; dt < 2; ++dt)
#pragma unroll
                            for (int ks = 0; ks < 4; ++ks) if (2 * db + dt < 5) cf[dt][ks] = *(const LAS bf16x8*)(Cs + (16 * (2 * db + dt) + fr) * MQ_STRIDE + ks * 64 + fq * 16);
                        __builtin_amdgcn_sched_barrier(0);
#pragma unroll
                        for (int ks = 0; ks < 4; ++ks)
#pragma unroll
                            for (int dt = 0; dt < 2; ++dt) if (2 * db + dt < 5) nacc[2 * db + dt] = __builtin_amdgcn_mfma_f32_16x16x32_bf16(cf[dt][ks], qf[ks], nacc[2 * db + dt], 0, 0, 0);
                        __builtin_amdgcn_sched_barrier(0);
                    }
                }
                const float inter = __expf(mp - Mt);
#pragma unroll
                for (int dt = 0; dt < 5; ++dt) nacc[dt] = nacc[dt] * inter;
#pragma unroll
                for (int jj = 0; jj < 4; ++jj) {
                    if (2 * jj <= wid) {
                        f32x4 s0 = {0.f, 0.f, 0.f, 0.f}, s1 = s0;
                        bf16x8 k0[4], k1[4], vfr[5];
                        const int vr = 32 * jj + 4 * fq + (fr >> 2);
#pragma unroll
                        for (int ks = 0; ks < 4; ++ks) {
                            k0[ks] = *(const LAS bf16x8*)(Ks + (32 * jj + fr) * MQ_STRIDE + ks * 64 + fq * 16);
                            k1[ks] = *(const LAS bf16x8*)(Ks + (32 * jj + 16 + fr) * MQ_STRIDE + ks * 64 + fq * 16);
                        }
                        __builtin_amdgcn_sched_barrier(0);
#pragma unroll
                        for (int ks = 0; ks < 4; ++ks) {
                            s0 = __builtin_amdgcn_mfma_f32_16x16x32_bf16(k0[ks], qf[ks], s0, 0, 0, 0);
                            s1 = __builtin_amdgcn_mfma_f32_16x16x32_bf16(k1[ks], qf[ks], s1, 0, 0, 0);
                        }
                        __builtin_amdgcn_sched_barrier(0);
#pragma unroll
                        for (int dt = 0; dt < 5; ++dt) vfr[dt] = tr_pair(Vs + vr * MV_STRIDE + (16 * dt + 4 * (fr & 3)) * 2, Vs + (vr + 16) * MV_STRIDE + (16 * dt + 4 * (fr & 3)) * 2);
                        const f32x4 a0 = *(const LAS f32x4*)(sa + 32 * jj + 4 * fq), a1 = *(const LAS f32x4*)(sa + 32 * jj + 16 + 4 * fq);
#pragma unroll
                        for (int i = 0; i < 4; ++i) {
                            const int sA = 32 * jj + 4 * fq + i, sB = sA + 16;
                            s0[i] = (sA <= t) ? s0[i] * __expf(a0[i] - Mt) : 0.f;
                            s1[i] = (sB <= t) ? s1[i] * __expf(a1[i] - Mt) : 0.f;
                        }
                        u32x4 w; w.x = pk2(s0[0], s0[1]); w.y = pk2(s0[2], s0[3]); w.z = pk2(s1[0], s1[1]); w.w = pk2(s1[2], s1[3]);
                        const bf16x8 pb = __builtin_bit_cast(bf16x8, w);
#pragma unroll
                        for (int dt = 0; dt < 5; ++dt) nacc[dt] = __builtin_amdgcn_mfma_f32_16x16x32_bf16(vfr[dt], pb, nacc[dt], 0, 0, 0);
                    }
                }
                const float dn = __shfl(nacc[4][0], fr);
                const float dd = fmaxf(fabsf(dn), __expf(-(bt + Mt)));
                const float inv = 1.0f / dd;
                bf16_t* op = Hout + MTOK(c * 128 + t) * D + hh * 256 + sl * 64 + 4 * fq;
                u32x2 w[4];
#pragma unroll
                for (int dt = 0; dt < 4; ++dt) { w[dt].x = pk2(nacc[dt][0] * inv, nacc[dt][1] * inv); w[dt].y = pk2(nacc[dt][2] * inv, nacc[dt][3] * inv); }
                { const bool odd = (fq & 1) != 0;
                  const u32x2 s01 = odd ? w[0] : w[1], s23 = odd ? w[2] : w[3];
                  u32x2 r01, r23; r01.x = __shfl_xor(s01.x, 16); r01.y = __shfl_xor(s01.y, 16); r23.x = __shfl_xor(s23.x, 16); r23.y = __shfl_xor(s23.y, 16);
                  const u32x4 o0 = odd ? (u32x4){r01.x, r01.y, w[1].x, w[1].y} : (u32x4){w[0].x, w[0].y, r01.x, r01.y};
                  const u32x4 o1 = odd ? (u32x4){r23.x, r23.y, w[3].x, w[3].y} : (u32x4){w[2].x, w[2].y, r23.x, r23.y};
                  bf16_t* ob = op - 4 * fq + 8 * (fq >> 1) + (odd ? 16 : 0);
                  __builtin_nontemporal_store(o0, (u32x4*)ob); __builtin_nontemporal_store(o1, (u32x4*)(ob + 32)); }
            }
            if (nown > 0) {
                const float decay = __expf(mp - M127);
#pragma unroll
                for (int dt = 0; dt < 5; ++dt) { Creg[0][dt] = Creg[0][dt] * decay; Creg[1][dt] = Creg[1][dt] * decay; }
#pragma unroll
                for (int jj = 0; jj < 4; ++jj) {
                    bf16x8 kb0, kb1, af[5];
                    const int sr = 32 * jj + 4 * fq + (fr >> 2);
                    kb0 = tr_pair(Ks + sr * MQ_STRIDE + (16 * wid + 4 * (fr & 3)) * 2, Ks + (sr + 16) * MQ_STRIDE + (16 * wid + 4 * (fr & 3)) * 2);
                    kb1 = kb0;
                    if (nown == 2) kb1 = tr_pair(Ks + sr * MQ_STRIDE + (16 * (wid + 6) + 4 * (fr & 3)) * 2, Ks + (sr + 16) * MQ_STRIDE + (16 * (wid + 6) + 4 * (fr & 3)) * 2);
#pragma unroll
                    for (int dt = 0; dt < 5; ++dt) af[dt] = tr_pair(VWs + sr * MV_STRIDE + (16 * dt + 4 * (fr & 3)) * 2, VWs + (sr + 16) * MV_STRIDE + (16 * dt + 4 * (fr & 3)) * 2);
                    __builtin_amdgcn_sched_barrier(0);
#pragma unroll
                    for (int dt = 0; dt < 5; ++dt) Creg[0][dt] = __builtin_amdgcn_mfma_f32_16x16x32_bf16(af[dt], kb0, Creg[0][dt], 0, 0, 0);
                    if (nown == 2) {
#pragma unroll
                        for (int dt = 0; dt < 5; ++dt) Creg[1][dt] = __builtin_amdgcn_mfma_f32_16x16x32_bf16(af[dt], kb1, Creg[1][dt], 0, 0, 0);
                    }
                    __builtin_amdgcn_sched_barrier(0);
                }
            }
            if (wid == 2 && c + 1 < nc) GATES(cur ^ 1);
            LBAR();
            if (nown > 0) {
#pragma unroll
                for (int dt = 0; dt < 5; ++dt)
#pragma unroll
                    for (int i = 0; i < 4; ++i)
                        *(LAS bf16_t*)(Cs + (16 * dt + 4 * fq + i) * MQ_STRIDE + (16 * wid + fr) * 2) = (bf16_t)(pk2(Creg[0][dt][i], 0.f) & 0xffffu);
                if (nown == 2) {
#pragma unroll
                    for (int dt = 0; dt < 5; ++dt)
#pragma unroll
                        for (int i = 0; i < 4; ++i)
                            *(LAS bf16_t*)(Cs + (16 * dt + 4 * fq + i) * MQ_STRIDE + (16 * (wid + 6) + fr) * 2) = (bf16_t)(pk2(Creg[1][dt][i], 0.f) & 0xffffu);
                }
            }
        }
#undef MLOAD
#undef GLOAD
#undef GATES
#undef MTOK
    }
    LBAR();
}

DI void mlstm_combine_phase(bf16_t* Hfw, const bf16_t* Hbw, const bf16_t* proj, const float* hn, int G, int bid) {
    int tid_ = threadIdx.x; asm volatile("" : "+v"(tid_)); asm volatile("" : "+s"(bid)); const int tid = tid_, wid = tid >> 6, lane = tid & 63;
    const int gw = bid * 8 + wid, NGW = G * 8;
    for (int row = gw; row < T; row += NGW) {
        bf16_t* fp = Hfw + (size_t)row * D + 16 * lane; const bf16_t* bp = Hbw + (size_t)row * D + 16 * lane; const bf16_t* op = proj + (size_t)row * NPROJ + 2048 + 16 * lane;
        float hs[16], ov[16]; float ss = 0.f;
#pragma unroll
        for (int q = 0; q < 2; ++q) {
            const u32x4 f = __builtin_nontemporal_load((const u32x4*)(fp + 8 * q)), b = __builtin_nontemporal_load((const u32x4*)(bp + 8 * q)), o = __builtin_nontemporal_load((const u32x4*)(op + 8 * q));
#pragma unroll
            for (int i = 0; i < 4; ++i) {
                hs[8 * q + 2 * i] = bflo(f[i]) + bflo(b[i]); hs[8 * q + 2 * i + 1] = bfhi(f[i]) + bfhi(b[i]);
                ov[8 * q + 2 * i] = bflo(o[i]); ov[8 * q + 2 * i + 1] = bfhi(o[i]);
            }
        }
#pragma unroll
        for (int i = 0; i < 16; ++i) ss += hs[i] * hs[i];
        ss += __shfl_xor(ss, 1); ss += __shfl_xor(ss, 2); ss += __shfl_xor(ss, 4); ss += __shfl_xor(ss, 8);
        const float rstd = rsqrtf(ss * (1.0f / 256.0f) + RMS_EPS);
#pragma unroll
        for (int q = 0; q < 2; ++q) {
            u32x4 w;
#pragma unroll
            for (int i = 0; i < 4; ++i) {
                const int e = 8 * q + 2 * i;
                const float y0 = hs[e] * rstd * hn[16 * lane + e] / (1.0f + __expf(-ov[e]));
                const float y1 = hs[e + 1] * rstd * hn[16 * lane + e + 1] / (1.0f + __expf(-ov[e + 1]));
                w[i] = pk2(y0, y1);
            }
            *(u32x4*)(fp + 8 * q) = w;
        }
    }
}

#define XB_TMO      128
#define XB_XCNT(j)  (256  + 64 * (j))
#define XB_XSUB(j)  (1280 + 64 * (j))
#define XB_XGEN(j)  (2304 + 64 * (j))
#define XB_TOP      3328
#define XB_TOPGEN   3392
#define XCD_BAR_WORDS 3456
#define XB_SPIN_CAP (1u << 18)
DI unsigned xb_ld(unsigned* p)              { return __hip_atomic_load(p, __ATOMIC_RELAXED, __HIP_MEMORY_SCOPE_AGENT); }
DI unsigned xb_add(unsigned* p, unsigned v) { return __hip_atomic_fetch_add(p, v, __ATOMIC_RELAXED, __HIP_MEMORY_SCOPE_AGENT); }
DI unsigned xb_xcc_id() { return (unsigned)__builtin_amdgcn_s_getreg((3 << 11) | 20) & 0xFu; }
#define XB_SPIN(cond, bar) do { unsigned _sp = 0; while (cond) { __builtin_amdgcn_s_sleep(1); \
    if ((++_sp & 255u) == 0u) { if (xb_ld(&(bar)[XB_TMO])) break; if (_sp > XB_SPIN_CAP) { atomicAdd(&(bar)[XB_TMO], 1u); break; } } } } while (0)
struct XcdBarrier { unsigned* bar; unsigned x; volatile LAS unsigned* st; };
DI XcdBarrier xcd_barrier_post(unsigned* bar, volatile LAS unsigned* st) {
    XcdBarrier b; b.bar = bar; b.x = xb_xcc_id(); b.st = st;
    if (threadIdx.x == 0) (void)xb_add(&bar[XB_XCNT(b.x)], 1u);
    return b;
}
DI void xcd_barrier_complete(unsigned* bar, unsigned x, unsigned& nloc, unsigned& nx) {
    const unsigned G = gridDim.x * gridDim.y * gridDim.z;
    unsigned sum, cnt, mine, sp = 0u;
    for (;;) {
        sum = 0u; cnt = 0u; mine = 0u;
#pragma unroll
        for (unsigned j = 0; j < 16; ++j) { const unsigned c = xb_ld(&bar[XB_XCNT(j)]); sum += c; cnt += (c > 0u) ? 1u : 0u; mine = (j == x) ? c : mine; }
        if (sum == G) break;
        __builtin_amdgcn_s_sleep(1);
        if ((++sp & 255u) == 0u) { if (xb_ld(&bar[XB_TMO])) break; if (sp > XB_SPIN_CAP) { atomicAdd(&bar[XB_TMO], 1u); break; } }
    }
    nloc = mine > 0u ? mine : 1u; nx = cnt > 0u ? cnt : 1u;
}
DI void xcd_barrier(const XcdBarrier& b) {
    asm volatile("s_waitcnt vmcnt(0)" ::: "memory");
    __syncthreads();
    if (threadIdx.x == 0) {
        unsigned* bar = b.bar;
        __builtin_amdgcn_s_waitcnt(0);
        unsigned nloc = b.st[0], nx = b.st[1];
        if (nloc == 0u) { xcd_barrier_complete(bar, b.x, nloc, nx); b.st[0] = nloc; b.st[1] = nx; }
        const unsigned old = xb_add(&bar[XB_XSUB(b.x)], 1u);
        const unsigned gen = old / nloc;
        if (old + 1u == (gen + 1u) * nloc) {
            __builtin_amdgcn_fence(__ATOMIC_RELEASE, "agent");
            asm volatile("s_waitcnt vmcnt(0)" ::: "memory");
            const unsigned og = xb_add(&bar[XB_TOP], 1u);
            const unsigned tg = og / nx;
            if (og + 1u == (tg + 1u) * nx) xb_add(&bar[XB_TOPGEN], 1u);
            else XB_SPIN(xb_ld(&bar[XB_TOPGEN]) == tg, bar);
            __builtin_amdgcn_fence(__ATOMIC_ACQUIRE, "agent");
            xb_add(&bar[XB_XGEN(b.x)], 1u);
            asm volatile("s_waitcnt vmcnt(0)" ::: "memory");
        } else {
            XB_SPIN(xb_ld(&bar[XB_XGEN(b.x)]) == gen, bar);
            __builtin_amdgcn_fence(__ATOMIC_ACQUIRE, "agent");
            asm volatile("s_waitcnt vmcnt(0)" ::: "memory");
        }
    }
    __syncthreads();
}

__global__ void __launch_bounds__(512, 2) fwd_megakernel(Args args) {
    extern __shared__ __attribute__((aligned(16))) unsigned char lds_raw[];
    LAS unsigned char* lds = (LAS unsigned char*)lds_raw;
    cg::grid_group grid = cg::this_grid();
    if (threadIdx.x < 16) ((LAS unsigned*)(lds + LDS_BYTES - 64))[threadIdx.x] = 0u;
    __syncthreads();
    const XcdBarrier xbar = xcd_barrier_post((unsigned*)(args.ws + WS_BAR), (volatile LAS unsigned*)(lds + LDS_BYTES - 64));
    const int G = gridDim.x, bid = blockIdx.x;
    unsigned char* ws = args.ws;
    float* mod = (float*)(ws + WS_MOD);
    float* xout = args.out;
    const float* xin_p = args.in[0]; const float* xin_s = args.in[1] - (size_t)TP * D;

#ifndef REP_GEMM
#define REP_GEMM 1
#endif
#ifndef REP_MLSTM
#define REP_MLSTM 1
#endif
#ifndef REP_NORM
#define REP_NORM 1
#endif
#define GEMM_PHASE(MODE, Aptr, Bptr, LDA, KK, NN, EPI) do { pg8::Gemm gm{(const bf16_t*)(Aptr), (const bf16_t*)(Bptr), (LDA), (KK), T, (NN)}; pg8::StaticOrder S; S.init(T, (NN), G, bid); \
        pg8::gemm_phase<MODE>(lds, gm, S, EPI); } while (0)
    const float* rope = (const float*)(ws + WS_ROPE);
    float* mod1 = mod + 16 * 6144;
    unsigned long long* rowq = (unsigned long long*)(ws + WS_ROWQ);
    float* lse = xout + OUT_LSE / 4;
#define EPI0(O_, ROPE_) pg8::Epi{(O_), (ROPE_), nullptr, nullptr, nullptr, nullptr, nullptr, nullptr, nullptr, nullptr, nullptr, nullptr, nullptr, nullptr, nullptr, 0}
#define EPI1(BP, BS, GT, ID, NG, NSH, NSC, HOUT, FIN) pg8::Epi{nullptr, nullptr, (BP), (BS), xout, (GT), nullptr, nullptr, nullptr, nullptr, rowq + (size_t)(ID) * T, (NG), (NSH), (NSC), (HOUT), (FIN)}
#ifdef PROBE_SYNC
    for (int i = 0; i < 20; ++i) grid.sync();
#endif
    prologue(lds, args, G, bid);
    if (G == 0x7fffffff) grid.sync();
    xcd_barrier(xbar);
    for (int rep = 0; rep < REP_NORM; ++rep) { normmod_phase(xin_p, xin_s, args.in[6], mod + 0, mod + 1024, (bf16_t*)xout, G, bid); if (rep + 1 < REP_NORM) xcd_barrier(xbar); }
    xcd_barrier(xbar);
    { pg8::Epi E = EPI0((bf16_t*)(ws + WS_R), rope);
      for (int rep = 0; rep < REP_GEMM; ++rep) { GEMM_PHASE(0, xout, ws + WS_WQKV, D, D, NQKV, E); if (rep + 1 < REP_GEMM) xcd_barrier(xbar); } }
    xcd_barrier(xbar);
    attn_phase(lds, (bf16_t*)(ws + WS_R), lse, G, bid);
    xcd_barrier(xbar);
    for (int rep = 0; rep < REP_NORM; ++rep) { attn_combine_phase((const bf16_t*)(ws + WS_R), lse, (bf16_t*)(ws + WS_Y), G, bid); if (rep + 1 < REP_NORM) xcd_barrier(xbar); }
    xcd_barrier(xbar);
    { pg8::Epi E = EPI1(xin_p, xin_s, mod + 2048, 0, args.in[9], mod + 3072, mod + 4096, (bf16_t*)(ws + WS_R), 0);
      GEMM_PHASE(1, ws + WS_Y, ws + WS_WO, 512, 512, D, E); }
    xcd_barrier(xbar);
    { pg8::Epi E = EPI0((bf16_t*)(ws + WS_B), nullptr);
      for (int rep = 0; rep < REP_GEMM; ++rep) { GEMM_PHASE(2, ws + WS_R, ws + WS_WGU0, D, D, NGU, E); if (rep + 1 < REP_GEMM) xcd_barrier(xbar); } }
    xcd_barrier(xbar);
    { pg8::Epi E = EPI1(xout, xout, mod + 5120, 1, args.in[14], mod1 + 0, mod1 + 1024, (bf16_t*)(ws + WS_R), 0);
      GEMM_PHASE(1, ws + WS_B, ws + WS_WDN0, FFH, FFH, D, E); }
    xcd_barrier(xbar);
    { pg8::Epi E = EPI0((bf16_t*)(ws + WS_B), nullptr); E.gates = (float*)(ws + WS_GATES); E.bg = args.in[16]; E.A3 = (const bf16_t*)(ws + WS_R); E.Wg = (const bf16_t*)(ws + WS_WIN) + (size_t)NPROJ * D;
      for (int rep = 0; rep < REP_GEMM; ++rep) { GEMM_PHASE(3, ws + WS_R, ws + WS_WIN, D, D, NPROJ, E); if (rep + 1 < REP_GEMM) xcd_barrier(xbar); } }
    xcd_barrier(xbar);
    for (int rep = 0; rep < REP_MLSTM; ++rep) { mlstm_phase(lds, (const bf16_t*)(ws + WS_B), (const float*)(ws + WS_GATES), (bf16_t*)(ws + WS_R), (bf16_t*)(ws + WS_HBW), G, bid); if (rep + 1 < REP_MLSTM) xcd_barrier(xbar); }
    xcd_barrier(xbar);
    mlstm_combine_phase((bf16_t*)(ws + WS_R), (const bf16_t*)(ws + WS_HBW), (const bf16_t*)(ws + WS_B), args.in[17], G, bid);
    xcd_barrier(xbar);
    { pg8::Epi E = EPI1(xout, xout, mod1 + 2048, 2, args.in[19], mod1 + 3072, mod1 + 4096, (bf16_t*)(ws + WS_B), 0);
      GEMM_PHASE(1, ws + WS_R, ws + WS_WOUT, D, D, D, E); }
    xcd_barrier(xbar);
    { pg8::Epi E = EPI0((bf16_t*)(ws + WS_HID1), nullptr);
      for (int rep = 0; rep < REP_GEMM; ++rep) { GEMM_PHASE(2, ws + WS_B, ws + WS_WGU1, D, D, NGU, E); if (rep + 1 < REP_GEMM) xcd_barrier(xbar); } }
    xcd_barrier(xbar);
    { pg8::Epi E = EPI1(xout, xout, mod1 + 5120, 3, args.in[22], nullptr, nullptr, nullptr, 1);
      GEMM_PHASE(1, ws + WS_HID1, ws + WS_WDN1, FFH, FFH, D, E); }
}

extern "C" void kernel_launch(void* const* d_in, const int* in_sizes, int n_in, void* d_out, int out_size, void* d_ws, size_t ws_size, hipStream_t stream) {
    static int grid = 0;
    if (grid == 0) {
        if (n_in != 23 || out_size != T * D || ws_size < WS_NEED) { fprintf(stderr, "kernel_launch: unexpected shapes (n_in %d out %d ws %zu)\n", n_in, out_size, ws_size); grid = -1; return; }
        int dev = 0, cus = 0, per_cu = 0;
        hipGetDevice(&dev);
        hipDeviceGetAttribute(&cus, hipDeviceAttributeMultiprocessorCount, dev);
        hipFuncSetAttribute((const void*)fwd_megakernel, hipFuncAttributeMaxDynamicSharedMemorySize, LDS_BYTES);
        hipOccupancyMaxActiveBlocksPerMultiprocessor(&per_cu, (const void*)fwd_megakernel, 512, LDS_BYTES);
        if (per_cu < 1) per_cu = 1;
        grid = cus * per_cu;
        (void)hipGetLastError();
    }
    if (grid < 0) return;
    hipMemsetAsync((char*)d_ws + WS_MOD, 0, WS_ZERO_BYTES, stream);
    Args a{};
    for (int i = 0; i < 23; ++i) a.in[i] = (const float*)d_in[i];
    a.out = (float*)d_out; a.ws = (unsigned char*)d_ws;
    void* kargs[] = {&a};
    hipError_t e = hipLaunchCooperativeKernel((const void*)fwd_megakernel, dim3(grid), dim3(512), kargs, LDS_BYTES, stream);
    if (e != hipSuccess) fprintf(stderr, "cooperative launch failed: %s (grid %d)\n", hipGetErrorString(e), grid);
}
```

```cpp
#include <hip/hip_runtime.h>
#include <hip/hip_cooperative_groups.h>
#include <cstdio>
#include <cstdint>
namespace cg = cooperative_groups;

#define LAS __attribute__((address_space(3)))
#define DI __device__ __forceinline__
typedef unsigned short bf16_t;
typedef short bf16x8 __attribute__((ext_vector_type(8)));
typedef short s16x4 __attribute__((ext_vector_type(4)));
typedef float f32x4 __attribute__((ext_vector_type(4)));
typedef float f32x2 __attribute__((ext_vector_type(2)));
typedef unsigned u32x4 __attribute__((ext_vector_type(4)));
typedef unsigned u32x2 __attribute__((ext_vector_type(2)));
typedef __bf16 bf16x2_t __attribute__((ext_vector_type(2)));
typedef short v4i16_t __attribute__((ext_vector_type(4)));

DI unsigned pk2(float lo, float hi) { f32x2 v = {lo, hi}; bf16x2_t b = __builtin_convertvector(v, bf16x2_t); return __builtin_bit_cast(unsigned, b); }
DI float bflo(unsigned u) { return __uint_as_float(u << 16); }
DI float bfhi(unsigned u) { return __uint_as_float(u & 0xffff0000u); }
DI float wave_sum(float v) {
#pragma unroll
    for (int o = 1; o < 64; o <<= 1) v += __shfl_xor(v, o);
    return v;
}
#define LBAR() do { asm volatile("s_waitcnt lgkmcnt(0)" ::: "memory"); __builtin_amdgcn_s_barrier(); asm volatile("" ::: "memory"); } while (0)

constexpr int D = 1024, TP = 65536, TSM = 32768, T = TP + TSM;
constexpr int NQKV = 4608, FFH = 2816, NGU = 5632, NIN = 3088, NINP = 3328, NPROJ = 3072;
constexpr float RMS_EPS = 1e-6f;
constexpr size_t MiB = 1u << 20;
constexpr size_t WS_MOD = 0;
constexpr size_t WS_BAR = 0xC4000;
constexpr size_t WS_ROWQ = 1 * MiB;
constexpr size_t WS_ZERO_BYTES = 4 * MiB;
constexpr size_t WS_ROPE = 4 * MiB;
constexpr size_t WS_WIN = 5 * MiB, WS_WOUT = 12 * MiB, WS_WGU1 = 14 * MiB, WS_WDN1 = 25 * MiB;
constexpr size_t WS_WQKV = 31 * MiB, WS_WO = 40 * MiB, WS_WGU0 = 41 * MiB, WS_WDN0 = 52 * MiB;
constexpr size_t WS_GATES = 31 * MiB;
constexpr size_t WS_R = 58 * MiB;
constexpr size_t WS_Y = 922 * MiB;
constexpr size_t WS_B = 250 * MiB;
constexpr size_t WS_HID1 = 442 * MiB;
constexpr size_t WS_HBW = 826 * MiB;
constexpr size_t WS_NEED = 1018 * MiB;
constexpr size_t OUT_LSE = 192 * MiB;
constexpr int LDS_BYTES = 147456;

DI int batch_of_row(int r) { return r < TP ? (r >> 13) : 8 + ((r - TP) >> 12); }
DI int pos_of_row(int r) { return r < TP ? (r & 8191) : ((r - TP) & 4095); }

namespace pg8 {
constexpr int BM = 256, BK = 64, HALF = 128, HTB = HALF * BK * 2, NXCD = 8, WGM = 8;
DI int lds_byte(int r, int c) { const int st = (r >> 4) * 2 + (c >> 5), rr = r & 15, cc = c & 31, ob = rr * 64 + cc * 2; return st * 1024 + (ob ^ (((ob >> 9) & 1) << 5)); }
DI void stage_rc(int b, int& R, int& C) { const int st = b / 1024, sb = b % 1024, swz = sb ^ (((sb >> 9) & 1) << 5); R = (st >> 1) * 16 + swz / 64; C = (st & 1) * 32 + (swz % 64) / 2; }
DI int perm32(int rho) { const int n = rho >> 4, i = rho & 15; return 8 * (i >> 2) + 4 * n + (i & 3); }
struct Unit { int pm, pn; };
struct Gemm { const bf16_t* A; const bf16_t* Bt; int lda, K, M, N; };
struct StaticOrder {
    int nM, nN, nwg, G, c;
    DI void init(int M, int N, int G_, int c_) { nM = M / BM; nN = N / BM; nwg = nM * nN; G = G_; c = c_; }
    DI bool next(int i, Unit& u) const {
        const long L = (long)i * G + c; if (L >= nwg) return false;
        int wgid = (int)L; { const int q = nwg / NXCD, r = nwg % NXCD, xcd = wgid % NXCD, off = wgid / NXCD; wgid = (xcd < r ? xcd * (q + 1) : r * (q + 1) + (xcd - r) * q) + off; }
        const int nig = WGM * nN, gid = wgid / nig, fm = gid * WGM, gsz = (nM - fm) < WGM ? (nM - fm) : WGM;
        u.pm = fm + ((wgid % nig) % gsz); u.pn = (wgid % nig) / gsz; return true;
    }
};

struct Epi {
    bf16_t* O;
    const float* rope;
    const float* base_p; const float* base_s; float* out; const float* gt;
    float* gates; const float* bg; const bf16_t* A3; const bf16_t* Wg;
    unsigned long long* rowq; const float* ng; const float* nsh; const float* nsc; bf16_t* hout; int fin;
};
DI float silu_f(float a) { return a * __builtin_amdgcn_rcpf(1.0f + __builtin_amdgcn_exp2f(-1.4426950408889634f * a)); }
template <int MODE> DI void epilogue(const Epi& E, f32x4 (&acc)[2][2][4][2], const Unit& u, int wr, int wc, int fr, int fq) {
    const int row0 = u.pm * BM + wr * 64 + fr;
    constexpr int emode = MODE;
    if constexpr (emode == 0) {
        const int colt = u.pn * BM; const int typ = (colt % 1536) >> 9;
        const bool rp = (typ < 2);
#pragma unroll
        for (int ai = 0; ai < 2; ++ai)
#pragma unroll
            for (int m = 0; m < 4; ++m) {
                const int row = row0 + ai * HALF + m * 16; const int pos = pos_of_row(row);
                f32x4 c0 = {1.f, 1.f, 1.f, 1.f}, c1 = c0, s0 = {0.f, 0.f, 0.f, 0.f}, s1 = s0;
                if (rp) { const f32x4* rt = (const f32x4*)(E.rope + (size_t)pos * 16); c0 = rt[0]; c1 = rt[1]; s0 = rt[2]; s1 = rt[3]; }
                const int pl0 = ((colt / 1536) * 3 + typ) * 8;
#pragma unroll
                for (int bj = 0; bj < 2; ++bj) {
                    const int hh_ = (((colt & 511) + wc * 64) >> 6);
                    bf16_t* rowp = E.O + ((size_t)(pl0 + hh_) * T + row) * 64 + bj * 32 + 8 * fq;
                    f32x4 v0 = acc[ai][bj][m][0], v1 = acc[ai][bj][m][1];
                    if (rp && bj == 0) {
                        f32x4 p0, p1;
#pragma unroll
                        for (int e = 0; e < 4; ++e) { p0[e] = __shfl_xor(v0[e], 16); p1[e] = __shfl_xor(v1[e], 16); }
                        if (fq == 0) { v0 = v0 * c0 - p0 * s0; v1 = v1 * c1 - p1 * s1; }
                        else if (fq == 1) { v0 = v0 * c0 + p0 * s0; v1 = v1 * c1 + p1 * s1; }
                    }
                    u32x4 w; w.x = pk2(v0[0], v0[1]); w.y = pk2(v0[2], v0[3]); w.z = pk2(v1[0], v1[1]); w.w = pk2(v1[2], v1[3]);
                    __builtin_nontemporal_store(w, (u32x4*)rowp);
                }
            }
    } else if constexpr (emode == 1) {
        const int bidx = batch_of_row(u.pm * BM);
        const char* base = (const char*)((u.pm * BM < TP) ? E.base_p : E.base_s);
        const int col0 = u.pn * BM + wc * 64 + 8 * fq;
        const unsigned ro = ((unsigned)row0 * D + (unsigned)col0) * 4u;
#define E1_OFF(ai, m, bj) (ro + (unsigned)(((ai) * HALF + (m) * 16) * D * 4 + (bj) * 32 * 4))
#pragma unroll
        for (int bj = 0; bj < 2; ++bj) {
            const f32x4 g0 = *(const f32x4*)(E.gt + bidx * 6144 + col0 + bj * 32), g1 = *(const f32x4*)(E.gt + bidx * 6144 + col0 + bj * 32 + 4);
#pragma unroll
            for (int ai = 0; ai < 2; ++ai)
#pragma unroll
                for (int m = 0; m < 4; ++m) {
                    const unsigned off = E1_OFF(ai, m, bj);
                    const f32x4 b0 = __builtin_nontemporal_load((const f32x4*)(base + off)), b1 = __builtin_nontemporal_load((const f32x4*)(base + off + 16));
                    acc[ai][bj][m][0] = b0 + g0 * acc[ai][bj][m][0];
                    acc[ai][bj][m][1] = b1 + g1 * acc[ai][bj][m][1];
                    asm volatile("" : "+v"(acc[ai][bj][m][0]), "+v"(acc[ai][bj][m][1]));
                }
            asm volatile("" ::: "memory");
        }
#pragma unroll
        for (int ai = 0; ai < 2; ++ai)
#pragma unroll
            for (int m = 0; m < 4; ++m) {
                float sq = 0.f;
#pragma unroll
                for (int bj = 0; bj < 2; ++bj)
#pragma unroll
                    for (int n = 0; n < 2; ++n) { const f32x4 v = acc[ai][bj][m][n]; sq += (v.x * v.x + v.y * v.y) + (v.z * v.z + v.w * v.w); }
                sq += __shfl_xor(sq, 16); sq += __shfl_xor(sq, 32);
                if (fq == 0) __hip_atomic_fetch_add(E.rowq + row0 + ai * HALF + m * 16, (1ull << 52) + (unsigned long long)(sq * 65536.0f + 0.5f), __ATOMIC_RELAXED, __HIP_MEMORY_SCOPE_AGENT);
            }
        if (!E.fin) {
            char* outp = (char*)E.out;
#pragma unroll
            for (int bj = 0; bj < 2; ++bj)
#pragma unroll
                for (int ai = 0; ai < 2; ++ai)
#pragma unroll
                    for (int m = 0; m < 4; ++m) {
                        const unsigned off = E1_OFF(ai, m, bj);
                        __builtin_nontemporal_store(acc[ai][bj][m][0], (f32x4*)(outp + off)); __builtin_nontemporal_store(acc[ai][bj][m][1], (f32x4*)(outp + off + 16));
                    }
        }
        float rs[2][4];
        { unsigned sp = 0;
          for (;;) {
              const unsigned long long ql = __hip_atomic_load(E.rowq + row0 + HALF + 48, __ATOMIC_RELAXED, __HIP_MEMORY_SCOPE_AGENT);
              if (__all((ql >> 52) >= 16ull)) {
                  bool done = true;
#pragma unroll
                  for (int ai = 0; ai < 2; ++ai)
#pragma unroll
                      for (int m = 0; m < 4; ++m) {
                          const unsigned long long q = __hip_atomic_load(E.rowq + row0 + ai * HALF + m * 16, __ATOMIC_RELAXED, __HIP_MEMORY_SCOPE_AGENT);
                          done = done && ((q >> 52) >= 16ull);
                          rs[ai][m] = rsqrtf((float)(q & ((1ull << 52) - 1ull)) * (1.0f / 65536.0f) * (1.0f / D) + RMS_EPS);
                      }
                  if (__all(done)) break;
              }
              __builtin_amdgcn_s_sleep(4);
              if (++sp > (1u << 18)) {
#pragma unroll
                  for (int ai = 0; ai < 2; ++ai)
#pragma unroll
                      for (int m = 0; m < 4; ++m) rs[ai][m] = 0.f;
                  break; }
          } }
#pragma unroll
        for (int bj = 0; bj < 2; ++bj) {
            const int c = col0 + bj * 32;
            f32x4 ga = *(const f32x4*)(E.ng + c), gb = *(const f32x4*)(E.ng + c + 4);
            f32x4 sha = {0.f, 0.f, 0.f, 0.f}, shb = sha;
            if (!E.fin) {
                const f32x4 sca = *(const f32x4*)(E.nsc + bidx * 6144 + c), scb = *(const f32x4*)(E.nsc + bidx * 6144 + c + 4);
                sha = *(const f32x4*)(E.nsh + bidx * 6144 + c); shb = *(const f32x4*)(E.nsh + bidx * 6144 + c + 4);
                ga = ga * (sca + 1.0f); gb = gb * (scb + 1.0f);
            }
#pragma unroll
            for (int ai = 0; ai < 2; ++ai)
#pragma unroll
                for (int m = 0; m < 4; ++m) {
                    const unsigned off = E1_OFF(ai, m, bj);
                    const f32x4 o0 = (acc[ai][bj][m][0] * rs[ai][m]) * ga + sha, o1 = (acc[ai][bj][m][1] * rs[ai][m]) * gb + shb;
                    if (E.fin) {
                        __builtin_nontemporal_store(o0, (f32x4*)((char*)E.out + off)); __builtin_nontemporal_store(o1, (f32x4*)((char*)E.out + off + 16));
                    } else {
                        u32x4 w; w.x = pk2(o0[0], o0[1]); w.y = pk2(o0[2], o0[3]); w.z = pk2(o1[0], o1[1]); w.w = pk2(o1[2], o1[3]);
                        *(u32x4*)((char*)E.hout + (off >> 1)) = w;
                    }
                }
        }
#undef E1_OFF
    } else if constexpr (emode == 2) {
        const int colh = u.pn * HALF + wc * 32 + 8 * fq;
#pragma unroll
        for (int ai = 0; ai < 2; ++ai)
#pragma unroll
            for (int m = 0; m < 4; ++m) {
                bf16_t* rowp = E.O + (size_t)(row0 + ai * HALF + m * 16) * FFH + colh;
                const f32x4 a0 = acc[ai][0][m][0], a1 = acc[ai][0][m][1], b0 = acc[ai][1][m][0], b1 = acc[ai][1][m][1];
                u32x4 w;
                w.x = pk2(silu_f(a0[0]) * b0[0], silu_f(a0[1]) * b0[1]); w.y = pk2(silu_f(a0[2]) * b0[2], silu_f(a0[3]) * b0[3]);
                w.z = pk2(silu_f(a1[0]) * b1[0], silu_f(a1[1]) * b1[1]); w.w = pk2(silu_f(a1[2]) * b1[2], silu_f(a1[3]) * b1[3]);
                __builtin_nontemporal_store(w, (u32x4*)rowp);
            }
    } else {
        if (u.pn < 12) {
            const int colt = u.pn * BM; const float sc = (colt >= 512 && colt < 1024) ? 0.08838834764831845f : 1.0f;
#pragma unroll
            for (int ai = 0; ai < 2; ++ai)
#pragma unroll
                for (int m = 0; m < 4; ++m) {
                    bf16_t* rowp = E.O + (size_t)(row0 + ai * HALF + m * 16) * NPROJ + colt + wc * 64 + 8 * fq;
#pragma unroll
                    for (int bj = 0; bj < 2; ++bj) {
                        const f32x4 v0 = acc[ai][bj][m][0] * sc, v1 = acc[ai][bj][m][1] * sc;
                        u32x4 w; w.x = pk2(v0[0], v0[1]); w.y = pk2(v0[2], v0[3]); w.z = pk2(v1[0], v1[1]); w.w = pk2(v1[2], v1[3]);
                        __builtin_nontemporal_store(w, (u32x4*)(rowp + bj * 32));
                    }
                }
        }
        if (u.pn == ((((u.pm >> 3) % 6)) & 3)) {
            const int r0 = u.pm * BM + (wr * 4 + wc) * 32;
            const bf16_t* Ap = E.A3 + (size_t)(r0 + fr) * D + fq * 8;
            const bf16_t* Bp = E.Wg + (size_t)fr * D + fq * 8;
            f32x4 g0 = {0.f, 0.f, 0.f, 0.f}, g1 = g0;
            for (int k0 = 0; k0 < 32; k0 += 8) {
                bf16x8 a0[8], a1[8], bq[8];
#pragma unroll
                for (int q = 0; q < 8; ++q) { a0[q] = *(const bf16x8*)(Ap + (k0 + q) * 32); a1[q] = *(const bf16x8*)(Ap + 16 * D + (k0 + q) * 32); bq[q] = *(const bf16x8*)(Bp + (k0 + q) * 32); }
#pragma unroll
                for (int q = 0; q < 8; ++q) { g0 = __builtin_amdgcn_mfma_f32_16x16x32_bf16(a0[q], bq[q], g0, 0, 0, 0); g1 = __builtin_amdgcn_mfma_f32_16x16x32_bf16(a1[q], bq[q], g1, 0, 0, 0); }
            }
            const float bgv = E.bg[fr];
#pragma unroll
            for (int i = 0; i < 4; ++i) {
                E.gates[(size_t)(r0 + 4 * fq + i) * 16 + fr] = g0[i] + bgv;
                E.gates[(size_t)(r0 + 16 + 4 * fq + i) * 16 + fr] = g1[i] + bgv;
            }
        }
    }
}

template <int MODE> DI void gemm_phase(LAS unsigned char* lds, const Gemm g, const StaticOrder& S, const Epi& E) {
    int tid_ = threadIdx.x; asm volatile("" : "+v"(tid_)); const int tid = tid_, wid = __builtin_amdgcn_readfirstlane(tid >> 6), lane = tid & 63, wr = wid >> 2, wc = wid & 3, fr = lane & 15, fq = lane >> 4;
    const int K = g.K, nt = K / BK, lda = g.lda;
    unsigned voffA[2], voffB[2];
#pragma unroll
    for (int i = 0; i < 2; ++i) { int R, C; stage_rc(tid * 16 + i * 8192, R, C);
        voffA[i] = (unsigned)(R * lda + C) * 2u; voffB[i] = (unsigned)((((R >> 5) * 64 + perm32(R & 31)) * K) + C) * 2u; }
    const size_t kstep = (size_t)(BK * 2);
    const size_t hstepA = (size_t)HALF * lda * 2, tstepA = 2 * hstepA;
    const size_t hstepB = (size_t)32 * K * 2, tstepB = (size_t)BM * K * 2;
    const unsigned ldsw = (unsigned)wid * 1024u;
    const int aoff = lds_byte(wr * 64 + fr, fq * 8), boff = lds_byte(wc * 32 + fr, fq * 8);
#define PG8_SA(b, h) (((b) * 2 + (h)) * HTB)
#define PG8_SB(b, h) ((4 + (b) * 2 + (h)) * HTB)
#define PG8_STAGE(bufoff, gbase, voff) do { _Pragma("unroll") for (int _i = 0; _i < 2; ++_i) \
        __builtin_amdgcn_global_load_lds((const unsigned*)((const char*)(gbase) + (voff)[_i]), (LAS unsigned*)(lds + (bufoff) + ldsw + _i * 8192), 16, 0, 0); } while (0)
#define PG8_LDA(dst, b, h) do { _Pragma("unroll") for (int m = 0; m < 4; ++m) _Pragma("unroll") for (int k = 0; k < 2; ++k) dst[m][k] = *(const LAS bf16x8*)(lds + PG8_SA(b, h) + aoff + m * 2048 + k * 1024); } while (0)
#define PG8_LDB(dst, b, h) do { _Pragma("unroll") for (int n = 0; n < 2; ++n) _Pragma("unroll") for (int k = 0; k < 2; ++k) dst[n][k] = *(const LAS bf16x8*)(lds + PG8_SB(b, h) + boff + n * 2048 + k * 1024); } while (0)
#define PG8_MMA(ai, bj, At, Bt) do { __builtin_amdgcn_s_setprio(1); _Pragma("unroll") for (int m = 0; m < 4; ++m) _Pragma("unroll") for (int n = 0; n < 2; ++n) _Pragma("unroll") for (int k = 0; k < 2; ++k) \
        acc[ai][bj][m][n] = __builtin_amdgcn_mfma_f32_16x16x32_bf16(Bt[n][k], At[m][k], acc[ai][bj][m][n], 0, 0, 0); __builtin_amdgcn_s_setprio(0); } while (0)
#define PG8_WAIT_V(n) asm volatile("s_waitcnt vmcnt(" #n ")" ::: "memory")
#define PG8_WAIT_L(n) asm volatile("s_waitcnt lgkmcnt(" #n ")" ::: "memory")
#define PG8_BAR __builtin_amdgcn_s_barrier()
#define PG8_SCHED __builtin_amdgcn_sched_barrier(0)
    Unit cur, nxt; int ui = 0;
    if (!S.next(0, cur)) return;
    f32x4 acc[2][2][4][2];
#pragma unroll
    for (int a = 0; a < 2; ++a)
#pragma unroll
        for (int b = 0; b < 2; ++b)
#pragma unroll
            for (int m = 0; m < 4; ++m)
#pragma unroll
                for (int n = 0; n < 2; ++n) acc[a][b][m][n] = (f32x4){0.f, 0.f, 0.f, 0.f};
    bf16x8 At[4][2], B0[2][2], B1[2][2];
    const char* cA = (const char*)g.A + (size_t)cur.pm * tstepA; const char* cB = (const char*)g.Bt + (size_t)cur.pn * tstepB;
    PG8_STAGE(PG8_SB(0, 0), cB, voffB); PG8_STAGE(PG8_SB(0, 1), cB + hstepB, voffB); PG8_STAGE(PG8_SA(0, 0), cA, voffA); PG8_STAGE(PG8_SA(0, 1), cA + hstepA, voffA);
    if (wr == 1) PG8_BAR;
    PG8_WAIT_V(2); PG8_BAR;
    PG8_STAGE(PG8_SB(1, 0), cB + kstep, voffB); PG8_STAGE(PG8_SA(1, 0), cA + kstep, voffA); PG8_STAGE(PG8_SB(1, 1), cB + hstepB + kstep, voffB);
    PG8_WAIT_V(6); PG8_BAR;
    for (;;) {
        const bool has_next = S.next(ui + 1, nxt);
        const char* nA = has_next ? (const char*)g.A + (size_t)nxt.pm * tstepA : cA; const char* nB = has_next ? (const char*)g.Bt + (size_t)nxt.pn * tstepB : cB;
        for (int t = 0; t < nt; t += 2) {
            const bool last = (t == nt - 2);
            const char* a1 = cA + (size_t)(t + 1) * kstep;
            const char* a2 = last ? nA : cA + (size_t)(t + 2) * kstep; const char* b2 = last ? nB : cB + (size_t)(t + 2) * kstep;
            const char* a3 = a2 + kstep; const char* b3 = b2 + kstep;
            PG8_LDB(B0, 0, 0); PG8_LDB(B1, 0, 1); PG8_SCHED; PG8_LDA(At, 0, 0); PG8_STAGE(PG8_SA(1, 1), a1 + hstepA, voffA);
            PG8_WAIT_V(8); PG8_WAIT_L(0); PG8_BAR; PG8_MMA(0, 0, At, B0); PG8_MMA(0, 1, At, B1); PG8_BAR; PG8_SCHED;
            PG8_LDA(At, 0, 1); PG8_STAGE(PG8_SB(0, 0), b2, voffB); PG8_STAGE(PG8_SB(0, 1), b2 + hstepB, voffB); PG8_STAGE(PG8_SA(0, 0), a2, voffA);
            PG8_WAIT_V(8); PG8_WAIT_L(0); PG8_BAR; PG8_MMA(1, 0, At, B0); PG8_MMA(1, 1, At, B1); PG8_BAR; PG8_SCHED;
            PG8_LDB(B0, 1, 0); PG8_LDB(B1, 1, 1); PG8_SCHED; PG8_LDA(At, 1, 0); PG8_STAGE(PG8_SA(0, 1), a2 + hstepA, voffA);
            PG8_WAIT_V(8); PG8_WAIT_L(0); PG8_BAR; PG8_MMA(0, 0, At, B0); PG8_MMA(0, 1, At, B1); PG8_BAR; PG8_SCHED;
            PG8_LDA(At, 1, 1); PG8_STAGE(PG8_SB(1, 0), b3, voffB); PG8_STAGE(PG8_SB(1, 1), b3 + hstepB, voffB); PG8_STAGE(PG8_SA(1, 0), a3, voffA);
            PG8_WAIT_V(8); PG8_WAIT_L(0); PG8_BAR; PG8_MMA(1, 0, At, B0); PG8_MMA(1, 1, At, B1); PG8_BAR; PG8_SCHED;
        }
        if (wr == 0) PG8_BAR;
        epilogue<MODE>(E, acc, cur, wr, wc, fr, fq);
        if (!has_next) break;
#pragma unroll
        for (int a = 0; a < 2; ++a)
#pragma unroll
            for (int b = 0; b < 2; ++b)
#pragma unroll
                for (int m = 0; m < 4; ++m)
#pragma unroll
                    for (int n = 0; n < 2; ++n) acc[a][b][m][n] = (f32x4){0.f, 0.f, 0.f, 0.f};
        cur = nxt; cA = nA; cB = nB; ++ui;
        if (wr == 1) PG8_BAR;
    }
    PG8_WAIT_V(0);
    PG8_BAR;
#undef PG8_SA
#undef PG8_SB
#undef PG8_STAGE
#undef PG8_LDA
#undef PG8_LDB
#undef PG8_MMA
#undef PG8_WAIT_V
#undef PG8_WAIT_L
#undef PG8_BAR
#undef PG8_SCHED
}
}

DI void transpose_item(const float* W, int K, int N, int ncols, bf16_t* WT, int gu, LAS float* scr, int item, int lane) {
    const int nblk = ncols / 32, kb = item / nblk, nb = item % nblk, k0 = 64 * kb, n0 = 32 * nb;
#pragma unroll 8
    for (int i = 0; i < 32; ++i) { const int kk = 2 * i + (lane >> 5); scr[kk * 33 + (lane & 31)] = W[(size_t)(k0 + kk) * N + n0 + (lane & 31)]; }
    asm volatile("s_waitcnt lgkmcnt(0)" ::: "memory");
    int r0 = n0;
    if (gu) { const int nn = (n0 < FFH) ? n0 : n0 - FFH; r0 = 256 * (nn >> 7) + 64 * ((nn & 127) >> 5) + ((n0 < FFH) ? 0 : 32); }
    const int c = lane & 7;
#pragma unroll
    for (int j = 0; j < 4; ++j) { const int n = (lane >> 3) + 8 * j; const LAS float* s = scr + (8 * c) * 33 + n;
        u32x4 o; o.x = pk2(s[0 * 33], s[1 * 33]); o.y = pk2(s[2 * 33], s[3 * 33]); o.z = pk2(s[4 * 33], s[5 * 33]); o.w = pk2(s[6 * 33], s[7 * 33]);
        *(u32x4*)(WT + (size_t)(r0 + n) * K + k0 + 8 * c) = o; }
    asm volatile("s_waitcnt lgkmcnt(0)" ::: "memory");
}

DI void sincos_d(double x, float& s, float& c) {
    const double q = __builtin_rint(x * 0.63661977236758134308);
    const double r = (x - q * 1.57079632679489655800) - q * 6.12323399573676603587e-17;
    const double r2 = r * r;
    double sp = 1.0 / 6227020800.0; sp = sp * r2 - 1.0 / 39916800.0; sp = sp * r2 + 1.0 / 362880.0; sp = sp * r2 - 1.0 / 5040.0; sp = sp * r2 + 1.0 / 120.0; sp = sp * r2 - 1.0 / 6.0; sp = sp * r2 + 1.0; sp *= r;
    double cp = -1.0 / 87178291200.0; cp = cp * r2 + 1.0 / 479001600.0; cp = cp * r2 - 1.0 / 3628800.0; cp = cp * r2 + 1.0 / 40320.0; cp = cp * r2 - 1.0 / 720.0; cp = cp * r2 + 1.0 / 24.0; cp = cp * r2 - 0.5; cp = cp * r2 + 1.0;
    const int qi = ((int)q) & 3;
    const double ss = (qi == 0) ? sp : (qi == 1) ? cp : (qi == 2) ? -sp : -cp;
    const double cc = (qi == 0) ? cp : (qi == 1) ? -sp : (qi == 2) ? -cp : sp;
    s = (float)ss; c = (float)cc;
}

struct Args { const float* in[23]; float* out; unsigned char* ws; };

DI void prologue(LAS unsigned char* lds, const Args& a, int G, int bid) {
    int tid_ = threadIdx.x; asm volatile("" : "+v"(tid_)); asm volatile("" : "+s"(bid)); const int tid = tid_, wid = __builtin_amdgcn_readfirstlane(tid >> 6), lane = tid & 63;
    LAS float* scr = (LAS float*)(lds + wid * 16384);
    unsigned char* ws = a.ws;
    const int gw = bid * 8 + wid, NGW = G * 8;
    constexpr int I_QKV = 16 * (NQKV / 32), I_WO = 8 * (D / 32), I_GU = 16 * (NGU / 32), I_DN = (FFH / 64) * (D / 32), I_IN = 16 * (NPROJ / 32), I_OUT = 16 * (D / 32);
    constexpr int NITEMS = I_QKV + I_WO + 2 * I_GU + 2 * I_DN + I_IN + I_OUT;
    for (int it = gw; it < NITEMS; it += NGW) {
        int r = it;
        if (r < I_QKV) { transpose_item(a.in[7], D, NQKV, NQKV, (bf16_t*)(ws + WS_WQKV), 0, scr, r, lane); continue; } r -= I_QKV;
        if (r < I_WO) { transpose_item(a.in[8], 512, D, D, (bf16_t*)(ws + WS_WO), 0, scr, r, lane); continue; } r -= I_WO;
        if (r < I_GU) { transpose_item(a.in[10], D, NGU, NGU, (bf16_t*)(ws + WS_WGU0), 1, scr, r, lane); continue; } r -= I_GU;
        if (r < I_DN) { transpose_item(a.in[11], FFH, D, D, (bf16_t*)(ws + WS_WDN0), 0, scr, r, lane); continue; } r -= I_DN;
        if (r < I_IN) { transpose_item(a.in[15], D, NIN, NPROJ, (bf16_t*)(ws + WS_WIN), 0, scr, r, lane); continue; } r -= I_IN;
        if (r < I_OUT) { transpose_item(a.in[18], D, D, D, (bf16_t*)(ws + WS_WOUT), 0, scr, r, lane); continue; } r -= I_OUT;
        if (r < I_GU) { transpose_item(a.in[20], D, NGU, NGU, (bf16_t*)(ws + WS_WGU1), 1, scr, r, lane); continue; } r -= I_GU;
        transpose_item(a.in[21], FFH, D, D, (bf16_t*)(ws + WS_WDN1), 0, scr, r, lane);
    }
    {
        bf16_t* wt = (bf16_t*)(ws + WS_WIN); const float* W = a.in[15];
        for (int e = bid * 512 + tid; e < 256 * D; e += G * 512) {
            const int rr = e >> 10, k = e & 1023; const int n = NPROJ + rr;
            float v = 0.f; if (n < NIN) v = W[(size_t)k * NIN + n];
            wt[(size_t)n * D + k] = (bf16_t)(pk2(v, 0.f) & 0xffffu);
        }
    }
    {
        float* rope = (float*)(ws + WS_ROPE);
        for (int e = bid * 512 + tid; e < 8192 * 8; e += G * 512) {
            const int pos = e >> 3, i = e & 7;
            const float inv = exp2f(-(float)i * 0.125f * 18.931568569324174f);
            const float ang = (float)pos * inv;
            float s, c; sincos_d((double)ang, s, c);
            rope[pos * 16 + i] = c; rope[pos * 16 + 8 + i] = s;
        }
    }
    {
        float* mod = (float*)(ws + WS_MOD);
        for (int it = gw; it < 2 * 96 * 16; it += NGW) {
            const int ks = it & 15, cb = (it >> 4) % 96, layer = it / (96 * 16);
            const float* W = a.in[layer ? 12 : 4]; const float* bias = a.in[layer ? 13 : 5];
            const int n = cb * 64 + lane, k0 = ks * 64;
#pragma unroll
            for (int b = 0; b < 16; ++b) {
                const float cv = (b < 8) ? a.in[2][b * D + k0 + lane] : a.in[3][(b - 8) * D + k0 + lane];
                scr[b * 64 + lane] = cv / (1.0f + __expf(-cv));
            }
            asm volatile("s_waitcnt lgkmcnt(0)" ::: "memory");
            float accm[16];
#pragma unroll
            for (int b = 0; b < 16; ++b) accm[b] = 0.f;
            for (int kk = 0; kk < 64; ++kk) {
                const float w = W[(size_t)(k0 + kk) * 6144 + n];
#pragma unroll
                for (int b = 0; b < 16; ++b) accm[b] += scr[b * 64 + kk] * w;
            }
            const float bv = (ks == 0) ? bias[n] : 0.f;
#pragma unroll
            for (int b = 0; b < 16; ++b) atomicAdd(mod + ((size_t)layer * 16 + b) * 6144 + n, accm[b] + bv);
            asm volatile("s_waitcnt lgkmcnt(0)" ::: "memory");
        }
    }
}

DI void normmod_phase(const float* xp, const float* xs, const float* g, const float* sh, const float* sc, bf16_t* out, int G, int bid) {
    int tid_ = threadIdx.x; asm volatile("" : "+v"(tid_)); asm volatile("" : "+s"(bid)); const int tid = tid_, wid = tid >> 6, lane = tid & 63;
    const int gw = bid * 8 + wid, NGW = G * 8;
    f32x4 v[4], u[4];
    int row = gw;
    if (row < T) { const float* src = (row < TP ? xp : xs) + (size_t)row * D;
#pragma unroll
        for (int j = 0; j < 4; ++j) v[j] = __builtin_nontemporal_load(((const f32x4*)src) + 64 * j + lane); }
    while (row < T) {
        const int nrow = row + NGW;
        if (nrow < T) { const float* src = (nrow < TP ? xp : xs) + (size_t)nrow * D;
#pragma unroll
            for (int j = 0; j < 4; ++j) u[j] = __builtin_nontemporal_load(((const f32x4*)src) + 64 * j + lane); }
        float ss = 0.f;
#pragma unroll
        for (int j = 0; j < 4; ++j) ss += (v[j].x * v[j].x + v[j].y * v[j].y) + (v[j].z * v[j].z + v[j].w * v[j].w);
        const float rstd = rsqrtf(wave_sum(ss) * (1.0f / D) + RMS_EPS);
        const int bidx = batch_of_row(row);
#pragma unroll
        for (int j = 0; j < 4; ++j) {
            const int c = 256 * j + 4 * lane;
            const f32x4 g4 = *(const f32x4*)(g + c), sc4 = *(const f32x4*)(sc + bidx * 6144 + c), sh4 = *(const f32x4*)(sh + bidx * 6144 + c);
            const f32x4 o = (v[j] * rstd) * g4 * (sc4 + 1.0f) + sh4;
            u32x2 w; w.x = pk2(o.x, o.y); w.y = pk2(o.z, o.w);
            *(u32x2*)(out + (size_t)row * D + c) = w;
        }
#pragma unroll
        for (int j = 0; j < 4; ++j) v[j] = u[j];
        row = nrow;
    }
}
DI void finalnorm_phase(float* x, const float* g, int G, int bid) {
    int tid_ = threadIdx.x; asm volatile("" : "+v"(tid_)); asm volatile("" : "+s"(bid)); const int tid = tid_, wid = tid >> 6, lane = tid & 63;
    const int gw = bid * 8 + wid, NGW = G * 8;
    for (int row = gw; row < T; row += NGW) {
        float* src = x + (size_t)row * D;
        f32x4 v[4]; float ss = 0.f;
#pragma unroll
        for (int j = 0; j < 4; ++j) { v[j] = ((const f32x4*)src)[64 * j + lane]; ss += (v[j].x * v[j].x + v[j].y * v[j].y) + (v[j].z * v[j].z + v[j].w * v[j].w); }
        const float rstd = rsqrtf(wave_sum(ss) * (1.0f / D) + RMS_EPS);
#pragma unroll
        for (int j = 0; j < 4; ++j) { const f32x4 g4 = *(const f32x4*)(g + 256 * j + 4 * lane); ((f32x4*)src)[64 * j + lane] = (v[j] * rstd) * g4; }
    }
}

constexpr int AK_STRIDE = 144, AV_STRIDE = 160, AK_BYTES = 384 * AK_STRIDE;
struct AttnUnit { int tok0, dsh, p, l0, L, g, h; };
DI AttnUnit attn_decode(int u) {
    AttnUnit a; a.h = u & 7; a.g = (u >> 3) % 3; const int tt = u / 24;
    int sg, S;
    if (tt < 256) { a.tok0 = (tt >> 5) * 8192; sg = tt & 31; S = 8192; } else { const int t2 = tt - 256; a.tok0 = TP + (t2 >> 4) * 4096; sg = t2 & 15; S = 4096; }
    a.dsh = 2 * a.g; a.L = S >> a.dsh; const int spp = a.L >> 8; a.p = sg / spp; a.l0 = (sg % spp) * 256;
    return a;
}
DI void attn_phase(LAS unsigned char* lds, bf16_t* QKV, float* lse, int G, int bid) {
    int tid_ = threadIdx.x; asm volatile("" : "+v"(tid_)); asm volatile("" : "+s"(bid)); const int tid = tid_, wid = __builtin_amdgcn_readfirstlane(tid >> 6), lane = tid & 63, fr = lane & 15, fq = lane >> 4;
    LAS unsigned char* Ks = lds; LAS unsigned char* Vs = lds + AK_BYTES;
    const int NU = (T / 256) * 24;
    const int bi = wid >> 1, half = wid & 1;
    u32x4 pk_[6], pv_[6]; bf16x8 pq_[2][2];
    if (bid < NU) {
        const AttnUnit a = attn_decode(bid);
        const bf16_t* qb = QKV + (size_t)((a.g * 3) * 8 + a.h) * T * 64; const bf16_t* kb = qb + (size_t)8 * T * 64; const bf16_t* vb = kb + (size_t)8 * T * 64;
#pragma unroll
        for (int ps = 0; ps < 6; ++ps) { const int rr = ps * 64 + (tid >> 3), ch = tid & 7, l = a.l0 - 64 + rr;
            u32x4 kv = {0u, 0u, 0u, 0u}, vv = kv;
            if (l >= 0 && l < a.L) { const size_t tok = (size_t)a.tok0 + ((size_t)l << a.dsh) + a.p; kv = *(const u32x4*)(kb + tok * 64 + ch * 8); vv = *(const u32x4*)(vb + tok * 64 + ch * 8); }
            pk_[ps] = kv; pv_[ps] = vv; }
#pragma unroll
        for (int qt = 0; qt < 2; ++qt) { const int l = a.l0 + 64 * bi + 32 * half + 16 * qt + fr; const size_t tok = (size_t)a.tok0 + ((size_t)l << a.dsh) + a.p;
#pragma unroll
            for (int ks = 0; ks < 2; ++ks) pq_[qt][ks] = *(const bf16x8*)(qb + tok * 64 + ks * 32 + fq * 8); }
    }
    for (int u = bid; u < NU; u += G) {
        const AttnUnit a = attn_decode(u);
        LBAR();
#pragma unroll
        for (int ps = 0; ps < 6; ++ps) { const int rr = ps * 64 + (tid >> 3), ch = tid & 7;
            *(LAS u32x4*)(Ks + rr * AK_STRIDE + ch * 16) = pk_[ps]; *(LAS u32x4*)(Vs + rr * AV_STRIDE + ch * 16) = pv_[ps]; }
        bf16x8 qf[2][2];
#pragma unroll
        for (int qt = 0; qt < 2; ++qt)
#pragma unroll
            for (int ks = 0; ks < 2; ++ks) qf[qt][ks] = pq_[qt][ks];
        if (u + G < NU) {
            const AttnUnit b = attn_decode(u + G);
            const bf16_t* qb = QKV + (size_t)((b.g * 3) * 8 + b.h) * T * 64; const bf16_t* kb = qb + (size_t)8 * T * 64; const bf16_t* vb = kb + (size_t)8 * T * 64;
#pragma unroll
            for (int ps = 0; ps < 6; ++ps) { const int rr = ps * 64 + (tid >> 3), ch = tid & 7, l = b.l0 - 64 + rr;
                u32x4 kv = {0u, 0u, 0u, 0u}, vv = kv;
                if (l >= 0 && l < b.L) { const size_t tok = (size_t)b.tok0 + ((size_t)l << b.dsh) + b.p; kv = *(const u32x4*)(kb + tok * 64 + ch * 8); vv = *(const u32x4*)(vb + tok * 64 + ch * 8); }
                pk_[ps] = kv; pv_[ps] = vv; }
#pragma unroll
            for (int qt = 0; qt < 2; ++qt) { const int l = b.l0 + 64 * bi + 32 * half + 16 * qt + fr; const size_t tok = (size_t)b.tok0 + ((size_t)l << b.dsh) + b.p;
#pragma unroll
                for (int ks = 0; ks < 2; ++ks) pq_[qt][ks] = *(const bf16x8*)(qb + tok * 64 + ks * 32 + fq * 8); }
        }
        LBAR();
        f32x4 sacc[10][2];
#pragma unroll
        for (int jt = 0; jt < 10; ++jt) { sacc[jt][0] = (f32x4){0.f, 0.f, 0.f, 0.f}; sacc[jt][1] = sacc[jt][0]; }
        const int krow0 = 64 * bi + 32 * half;
#pragma unroll
        for (int jb = 0; jb < 5; ++jb) {
            bf16x8 kf[2][2];
#pragma unroll
            for (int j5 = 0; j5 < 2; ++j5)
#pragma unroll
                for (int ks = 0; ks < 2; ++ks) kf[j5][ks] = *(const LAS bf16x8*)(Ks + (krow0 + 16 * (2 * jb + j5) + fr) * AK_STRIDE + ks * 64 + fq * 16);
            __builtin_amdgcn_sched_barrier(0);
#pragma unroll
            for (int ks = 0; ks < 2; ++ks)
#pragma unroll
                for (int j5 = 0; j5 < 2; ++j5) {
                    if (2 * jb + j5 <= 8) sacc[2 * jb + j5][0] = __builtin_amdgcn_mfma_f32_16x16x32_bf16(kf[j5][ks], qf[0][ks], sacc[2 * jb + j5][0], 0, 0, 0);
                    if (2 * jb + j5 >= 1) sacc[2 * jb + j5][1] = __builtin_amdgcn_mfma_f32_16x16x32_bf16(kf[j5][ks], qf[1][ks], sacc[2 * jb + j5][1], 0, 0, 0);
                }
            __builtin_amdgcn_sched_barrier(0);
        }
        const float SC = 0.125f * 1.4426950408889634f;
        float mx[2], den[2];
        const int lkb = a.l0 + 64 * bi - 64 + 32 * half;
        const bool edge = (lkb < 0) || (lkb + 160 > a.L);
#pragma unroll
        for (int qt = 0; qt < 2; ++qt) {
            float m = -1e30f;
#pragma unroll
            for (int jt = 0; jt < 10; ++jt) {
                const int dj = jt - qt;
                if (dj < 0 || dj > 8) continue;
#pragma unroll
                for (int i = 0; i < 4; ++i) {
                    float sv = sacc[jt][qt][i];
                    if (dj == 0) sv = (4 * fq + i >= fr) ? sv : -1e30f;
                    if (dj == 8) sv = (4 * fq + i <= fr) ? sv : -1e30f;
                    if (edge) { const int lk = lkb + 16 * jt + 4 * fq + i; sv = (lk >= 0 && lk < a.L) ? sv : -1e30f; }
                    sacc[jt][qt][i] = sv; m = fmaxf(m, sv);
                }
            }
            m = fmaxf(m, __shfl_xor(m, 16)); m = fmaxf(m, __shfl_xor(m, 32));
            m *= SC;
            float d = 0.f;
#pragma unroll
            for (int jt = 0; jt < 10; ++jt) {
                const int dj = jt - qt;
                if (dj < 0 || dj > 8) { sacc[jt][qt] = (f32x4){0.f, 0.f, 0.f, 0.f}; continue; }
#pragma unroll
                for (int i = 0; i < 4; ++i) { const float p = __builtin_amdgcn_exp2f(__builtin_fmaf(sacc[jt][qt][i], SC, -m)); sacc[jt][qt][i] = p; d += p; }
            }
            d += __shfl_xor(d, 16); d += __shfl_xor(d, 32);
            mx[qt] = m; den[qt] = d;
        }
        f32x4 oacc[4][2];
#pragma unroll
        for (int dt = 0; dt < 4; ++dt) { oacc[dt][0] = (f32x4){0.f, 0.f, 0.f, 0.f}; oacc[dt][1] = oacc[dt][0]; }
#pragma unroll
        for (int jj = 0; jj < 5; ++jj) {
            bf16x8 pb[2];
#pragma unroll
            for (int qt = 0; qt < 2; ++qt) {
                u32x4 w; w.x = pk2(sacc[2 * jj][qt][0], sacc[2 * jj][qt][1]); w.y = pk2(sacc[2 * jj][qt][2], sacc[2 * jj][qt][3]);
                w.z = pk2(sacc[2 * jj + 1][qt][0], sacc[2 * jj + 1][qt][1]); w.w = pk2(sacc[2 * jj + 1][qt][2], sacc[2 * jj + 1][qt][3]);
                pb[qt] = __builtin_bit_cast(bf16x8, w);
            }
            const int vr = krow0 + 32 * jj + 4 * fq + (fr >> 2);
            bf16x8 vf[4];
#pragma unroll
            for (int dt = 0; dt < 4; ++dt) {
                const s16x4 lo = __builtin_bit_cast(s16x4, __builtin_amdgcn_ds_read_tr16_b64_v4i16((LAS v4i16_t*)(Vs + vr * AV_STRIDE + (16 * dt + 4 * (fr & 3)) * 2)));
                const s16x4 hi = __builtin_bit_cast(s16x4, __builtin_amdgcn_ds_read_tr16_b64_v4i16((LAS v4i16_t*)(Vs + (vr + 16) * AV_STRIDE + (16 * dt + 4 * (fr & 3)) * 2)));
                vf[dt] = (bf16x8){lo[0], lo[1], lo[2], lo[3], hi[0], hi[1], hi[2], hi[3]};
            }
            __builtin_amdgcn_sched_barrier(0);
#pragma unroll
            for (int dt = 0; dt < 4; ++dt) {
                oacc[dt][0] = __builtin_amdgcn_mfma_f32_16x16x32_bf16(vf[dt], pb[0], oacc[dt][0], 0, 0, 0);
                oacc[dt][1] = __builtin_amdgcn_mfma_f32_16x16x32_bf16(vf[dt], pb[1], oacc[dt][1], 0, 0, 0);
            }
            __builtin_amdgcn_sched_barrier(0);
        }
#pragma unroll
        for (int qt = 0; qt < 2; ++qt) {
            const int l = a.l0 + 64 * bi + 32 * half + 16 * qt + fr; const size_t tok = (size_t)a.tok0 + ((size_t)l << a.dsh) + a.p;
            const float inv = 1.0f / den[qt];
            bf16_t* op = QKV + ((size_t)((a.g * 3) * 8 + a.h) * T + tok) * 64 + 4 * fq;
            u32x2 w[4];
#pragma unroll
            for (int dt = 0; dt < 4; ++dt) { w[dt].x = pk2(oacc[dt][qt][0] * inv, oacc[dt][qt][1] * inv); w[dt].y = pk2(oacc[dt][qt][2] * inv, oacc[dt][qt][3] * inv); }
            { const bool odd = (fq & 1) != 0;
              const u32x2 s01 = odd ? w[0] : w[1], s23 = odd ? w[2] : w[3];
              u32x2 r01, r23; r01.x = __shfl_xor(s01.x, 16); r01.y = __shfl_xor(s01.y, 16); r23.x = __shfl_xor(s23.x, 16); r23.y = __shfl_xor(s23.y, 16);
              const u32x4 o0 = odd ? (u32x4){r01.x, r01.y, w[1].x, w[1].y} : (u32x4){w[0].x, w[0].y, r01.x, r01.y};
              const u32x4 o1 = odd ? (u32x4){r23.x, r23.y, w[3].x, w[3].y} : (u32x4){w[2].x, w[2].y, r23.x, r23.y};
              bf16_t* ob = op - 4 * fq + 8 * (fq >> 1) + (odd ? 16 : 0);
              __builtin_nontemporal_store(o0, (u32x4*)ob); __builtin_nontemporal_store(o1, (u32x4*)(ob + 32)); }
            if (fq == 0) lse[tok * 24 + a.g * 8 + a.h] = (mx[qt] + __builtin_amdgcn_logf(den[qt])) * 0.6931471805599453f;
        }
    }
    LBAR();
}

DI void attn_combine_phase(const bf16_t* QKV, const float* lse, bf16_t* Y, int G, int bid) {
    int tid_ = threadIdx.x; asm volatile("" : "+v"(tid_)); asm volatile("" : "+s"(bid)); const int tid = tid_, wid = tid >> 6, lane = tid & 63;
    const int gw = bid * 8 + wid, NGW = G * 8;
    const int ts = lane >> 3, ch = lane & 7;
    for (int t8 = gw; t8 < T / 8; t8 += NGW) {
        const size_t tok = (size_t)t8 * 8 + ts;
        const float* lp = lse + tok * 24;
#pragma unroll 2
        for (int h = 0; h < 8; ++h) {
            const u32x4 o0 = __builtin_nontemporal_load((const u32x4*)(QKV + ((size_t)(0 * 8 + h) * T + tok) * 64 + ch * 8));
            const u32x4 o1 = __builtin_nontemporal_load((const u32x4*)(QKV + ((size_t)(3 * 8 + h) * T + tok) * 64 + ch * 8));
            const u32x4 o2 = __builtin_nontemporal_load((const u32x4*)(QKV + ((size_t)(6 * 8 + h) * T + tok) * 64 + ch * 8));
            const float l0 = lp[h], l1 = lp[8 + h], l2 = lp[16 + h];
            const float m = fmaxf(l0, fmaxf(l1, l2));
            float e0 = __expf(l0 - m), e1 = __expf(l1 - m), e2 = __expf(l2 - m);
            const float inv = 1.0f / (e0 + e1 + e2); e0 *= inv; e1 *= inv; e2 *= inv;
            u32x4 w;
#pragma unroll
            for (int i = 0; i < 4; ++i) {
                const float lo = e0 * bflo(o0[i]) + e1 * bflo(o1[i]) + e2 * bflo(o2[i]);
                const float hi = e0 * bfhi(o0[i]) + e1 * bfhi(o1[i]) + e2 * bfhi(o2[i]);
                w[i] = pk2(lo, hi);
            }
            *(u32x4*)(Y + tok * 512 + h * 64 + ch * 8) = w;
        }
    }
}

constexpr int MQ_STRIDE = 272, MV_STRIDE = 160;
constexpr int M_QS = 0, M_KS = 34816, M_VS = 69632, M_VWS = 90112, M_CS = 110592, M_SM = 132352;
DI float logsig(float x) { return fminf(x, 0.f) - log1pf(__expf(-fabsf(x))); }
DI bf16x8 tr_pair(const LAS unsigned char* p0, const LAS unsigned char* p1) {
    const s16x4 lo = __builtin_bit_cast(s16x4, __builtin_amdgcn_ds_read_tr16_b64_v4i16((LAS v4i16_t*)p0));
    const s16x4 hi = __builtin_bit_cast(s16x4, __builtin_amdgcn_ds_read_tr16_b64_v4i16((LAS v4i16_t*)p1));
    return (bf16x8){lo[0], lo[1], lo[2], lo[3], hi[0], hi[1], hi[2], hi[3]};
}
DI void mlstm_phase(LAS unsigned char* lds, const bf16_t* proj, const float* gates, bf16_t* Hfw, bf16_t* Hbw, int G, int bid) {
    int tid_ = threadIdx.x; asm volatile("" : "+v"(tid_)); asm volatile("" : "+s"(bid)); const int tid = tid_, wid = __builtin_amdgcn_readfirstlane(tid >> 6), lane = tid & 63, fr = lane & 15, fq = lane >> 4;
    LAS unsigned char* Qs = lds + M_QS; LAS unsigned char* Ks = lds + M_KS; LAS unsigned char* Vs = lds + M_VS; LAS unsigned char* VWs = lds + M_VWS; LAS unsigned char* Cs = lds + M_CS;
    LAS float* smal = (LAS float*)(lds + M_SM);
    for (int item = bid; item < 512; item += G) {
        const int it_ = item & 255; const bool lng = item < 256;
        const int it = ((((it_ >> 3) >> 2) * 8 + (it_ & 7)) << 2) | ((it_ >> 3) & 3);
        const int sl = it & 3, dir = (it >> 2) & 1, hh = (it >> 3) & 3, b = it >> 5;
        const int S = lng ? 8192 : 4096; const int tok0 = lng ? b * 8192 : TP + b * 4096; const int nc = S >> 7;
        bf16_t* Hout = dir ? Hbw : Hfw;
        const int gcol = dir * 8 + hh;
        LBAR();
        for (int i = tid; i < 80 * MQ_STRIDE / 4; i += 512) ((LAS unsigned*)Cs)[i] = 0u;
        if (tid < 128) { LAS unsigned* p = (LAS unsigned*)(Vs + tid * MV_STRIDE + 128); unsigned z = 0u; asm volatile("" : "+v"(z)); p[0] = 0x3F80u | z;
#pragma unroll
            for (int i = 1; i < 8; ++i) p[i] = z; }
        const int nown = (wid < 2) ? 2 : ((wid < 6) ? 1 : 0);
        f32x4 Creg[2][5];
#pragma unroll
        for (int dt = 0; dt < 5; ++dt) { Creg[0][dt] = (f32x4){0.f, 0.f, 0.f, 0.f}; Creg[1][dt] = Creg[0][dt]; }
        float mprev = 0.f;
        u32x4 pq[4], pk[4], pv[2]; float gi0 = 0.f, gi1 = 0.f, gf0 = 0.f, gf1 = 0.f;
#define MTOK(tau) ((size_t)tok0 + (size_t)(dir ? (S - 1 - (tau)) : (tau)))
#define MLOAD(c) do { \
            _Pragma("unroll") for (int i = 0; i < 4; ++i) { const int ci = tid + 512 * i, row = ci >> 4, ch = ci & 15; const bf16_t* rp = proj + MTOK((c) * 128 + row) * NPROJ; \
                pq[i] = *(const u32x4*)(rp + hh * 128 + ch * 8); pk[i] = *(const u32x4*)(rp + 512 + hh * 128 + ch * 8); } \
            _Pragma("unroll") for (int i = 0; i < 2; ++i) { const int ci = tid + 512 * i, row = ci >> 3, ch = ci & 7; const bf16_t* rp = proj + MTOK((c) * 128 + row) * NPROJ; \
                pv[i] = *(const u32x4*)(rp + 1024 + hh * 256 + sl * 64 + ch * 8); } } while (0)
#define GLOAD(c) do { const float* g0 = gates + MTOK((c) * 128 + 2 * lane) * 16; const float* g1 = gates + MTOK((c) * 128 + 2 * lane + 1) * 16; \
                gi0 = g0[gcol]; gf0 = g0[gcol + 4]; gi1 = g1[gcol]; gf1 = g1[gcol + 4]; } while (0)
#define GATES(bufi) do { LAS float* sa_ = smal + (bufi) * 388; LAS float* sM_ = sa_ + 128; LAS float* sb_ = sa_ + 256; LAS float* scl_ = sa_ + 384; \
                const float lf0 = logsig(gf0), lf1 = logsig(gf1); const float ps = lf0 + lf1; float inc = ps; \
                _Pragma("unroll") for (int o = 1; o < 64; o <<= 1) { const float t = __shfl_up(inc, o); if (lane >= o) inc += t; } \
                const float b0 = inc - ps + lf0, b1 = inc; const float a0 = gi0 - b0, a1 = gi1 - b1; float imx = fmaxf(a0, a1); \
                _Pragma("unroll") for (int o = 1; o < 64; o <<= 1) { const float t = __shfl_up(imx, o); if (lane >= o) imx = fmaxf(imx, t); } \
                float exm = __shfl_up(imx, 1); if (lane == 0) exm = -1e30f; \
                const float M0 = fmaxf(mprev, fmaxf(exm, a0)), M1 = fmaxf(mprev, imx); \
                sa_[2 * lane] = a0; sa_[2 * lane + 1] = a1; sM_[2 * lane] = M0; sM_[2 * lane + 1] = M1; sb_[2 * lane] = b0; sb_[2 * lane + 1] = b1; \
                const float M127_ = __shfl(M1, 63), b127_ = __shfl(b1, 63); \
                if (lane == 0) { scl_[0] = mprev; scl_[1] = M127_; } \
                mprev = b127_ + M127_; } while (0)
        MLOAD(0);
        if (wid == 2) { GLOAD(0); GATES(0); }
        LBAR();
        for (int c = 0; c < nc; ++c) {
            const int cur = c & 1;
            LAS float* sa = smal + cur * 388; LAS float* sM = sa + 128; LAS float* sb = sa + 256; LAS float* scl = sa + 384;
            const float mp = scl[0], M127 = scl[1];
#pragma unroll
            for (int i = 0; i < 4; ++i) { const int ci = tid + 512 * i, row = ci >> 4, ch = ci & 15;
                *(LAS u32x4*)(Qs + row * MQ_STRIDE + ch * 16) = pq[i]; *(LAS u32x4*)(Ks + row * MQ_STRIDE + ch * 16) = pk[i]; }
#pragma unroll
            for (int i = 0; i < 2; ++i) { const int ci = tid + 512 * i, row = ci >> 3, ch = ci & 7;
                *(LAS u32x4*)(Vs + row * MV_STRIDE + ch * 16) = pv[i];
                const float wsv = __expf(sa[row] - M127);
                u32x4 w;
#pragma unroll
                for (int e = 0; e < 4; ++e) w[e] = pk2(bflo(pv[i][e]) * wsv, bfhi(pv[i][e]) * wsv);
                *(LAS u32x4*)(VWs + row * MV_STRIDE + ch * 16) = w;
                if (ch == 0) { const u32x4 x0 = {pk2(wsv, 0.f), 0u, 0u, 0u}, x1 = {0u, 0u, 0u, 0u};
                    *(LAS u32x4*)(VWs + row * MV_STRIDE + 128) = x0; *(LAS u32x4*)(VWs + row * MV_STRIDE + 144) = x1; }
            }
            if (c + 1 < nc) { MLOAD(c + 1); if (wid == 2) GLOAD(c + 1); }
            LBAR();
            {
                const int t = 16 * wid + fr;
                bf16x8 qf[4];
#pragma unroll
                for (int ks = 0; ks < 4; ++ks) qf[ks] = *(const LAS bf16x8*)(Qs + t * MQ_STRIDE + ks * 64 + fq * 16);
                const float Mt = sM[t], bt = sb[t];
                f32x4 nacc[5];
                {
                    bf16x8 cf[2][4];
#pragma unroll
                    for (int dt = 0; dt < 5; ++dt) nacc[dt] = (f32x4){0.f, 0.f, 0.f, 0.f};
#pragma unroll
                    for (int db = 0; db < 3; ++db) {
#pragma unroll
                        for (int dt = 0; dt < 2; ++dt)
#pragma unroll
                            for (int ks = 0; ks < 4; ++ks) if (2 * db + dt < 5) cf[dt][ks] = *(const LAS bf16x8*)(Cs + (16 * (2 * db + dt) + fr) * MQ_STRIDE + ks * 64 + fq * 16);
                        __builtin_amdgcn_sched_barrier(0);
#pragma unroll
                        for (int ks = 0; ks < 4; ++ks)
#pragma unroll
                            for (int dt = 0; dt < 2; ++dt) if (2 * db + dt < 5) nacc[2 * db + dt] = __builtin_amdgcn_mfma_f32_16x16x32_bf16(cf[dt][ks], qf[ks], nacc[2 * db + dt], 0, 0, 0);
                        __builtin_amdgcn_sched_barrier(0);
                    }
                }
                const float inter = __expf(mp - Mt);
#pragma unroll
                for (int dt = 0; dt < 5; ++dt) nacc[dt] = nacc[dt] * inter;
#pragma unroll
                for (int jj = 0; jj < 4; ++jj) {
                    if (2 * jj <= wid) {
                        f32x4 s0 = {0.f, 0.f, 0.f, 0.f}, s1 = s0;
                        bf16x8 k0[4], k1[4], vfr[5];
                        const int vr = 32 * jj + 4 * fq + (fr >> 2);
#pragma unroll
                        for (int ks = 0; ks < 4; ++ks) {
                            k0[ks] = *(const LAS bf16x8*)(Ks + (32 * jj + fr) * MQ_STRIDE + ks * 64 + fq * 16);
                            k1[ks] = *(const LAS bf16x8*)(Ks + (32 * jj + 16 + fr) * MQ_STRIDE + ks * 64 + fq * 16);
                        }
                        __builtin_amdgcn_sched_barrier(0);
#pragma unroll
                        for (int ks = 0; ks < 4; ++ks) {
                            s0 = __builtin_amdgcn_mfma_f32_16x16x32_bf16(k0[ks], qf[ks], s0, 0, 0, 0);
                            s1 = __builtin_amdgcn_mfma_f32_16x16x32_bf16(k1[ks], qf[ks], s1, 0, 0, 0);
                        }
                        __builtin_amdgcn_sched_barrier(0);
#pragma unroll
                        for (int dt = 0; dt < 5; ++dt) vfr[dt] = tr_pair(Vs + vr * MV_STRIDE + (16 * dt + 4 * (fr & 3)) * 2, Vs + (vr + 16) * MV_STRIDE + (16 * dt + 4 * (fr & 3)) * 2);
                        const f32x4 a0 = *(const LAS f32x4*)(sa + 32 * jj + 4 * fq), a1 = *(const LAS f32x4*)(sa + 32 * jj + 16 + 4 * fq);
#pragma unroll
                        for (int i = 0; i < 4; ++i) {
                            const int sA = 32 * jj + 4 * fq + i, sB = sA + 16;
                            s0[i] = (sA <= t) ? s0[i] * __expf(a0[i] - Mt) : 0.f;
                            s1[i] = (sB <= t) ? s1[i] * __expf(a1[i] - Mt) : 0.f;
                        }
                        u32x4 w; w.x = pk2(s0[0], s0[1]); w.y = pk2(s0[2], s0[3]); w.z = pk2(s1[0], s1[1]); w.w = pk2(s1[2], s1[3]);
                        const bf16x8 pb = __builtin_bit_cast(bf16x8, w);
#pragma unroll
                        for (int dt = 0; dt < 5; ++dt) nacc[dt] = __builtin_amdgcn_mfma_f32_16x16x32_bf16(vfr[dt], pb, nacc[dt], 0, 0, 0);
                    }
                }
                const float dn = __shfl(nacc[4][0], fr);
                const float dd = fmaxf(fabsf(dn), __expf(-(bt + Mt)));
                const float inv = 1.0f / dd;
                bf16_t* op = Hout + MTOK(c * 128 + t) * D + hh * 256 + sl * 64 + 4 * fq;
                u32x2 w[4];
#pragma unroll
                for (int dt = 0; dt < 4; ++dt) { w[dt].x = pk2(nacc[dt][0] * inv, nacc[dt][1] * inv); w[dt].y = pk2(nacc[dt][2] * inv, nacc[dt][3] * inv); }
                { const bool odd = (fq & 1) != 0;
                  const u32x2 s01 = odd ? w[0] : w[1], s23 = odd ? w[2] : w[3];
                  u32x2 r01, r23; r01.x = __shfl_xor(s01.x, 16); r01.y = __shfl_xor(s01.y, 16); r23.x = __shfl_xor(s23.x, 16); r23.y = __shfl_xor(s23.y, 16);
                  const u32x4 o0 = odd ? (u32x4){r01.x, r01.y, w[1].x, w[1].y} : (u32x4){w[0].x, w[0].y, r01.x, r01.y};
                  const u32x4 o1 = odd ? (u32x4){r23.x, r23.y, w[3].x, w[3].y} : (u32x4){w[2].x, w[2].y, r23.x, r23.y};
                  bf16_t* ob = op - 4 * fq + 8 * (fq >> 1) + (odd ? 16 : 0);
                  __builtin_nontemporal_store(o0, (u32x4*)ob); __builtin_nontemporal_store(o1, (u32x4*)(ob + 32)); }
            }
            if (nown > 0) {
                const float decay = __expf(mp - M127);
#pragma unroll
                for (int dt = 0; dt < 5; ++dt) { Creg[0][dt] = Creg[0][dt] * decay; Creg[1][dt] = Creg[1][dt] * decay; }
#pragma unroll
                for (int jj = 0; jj < 4; ++jj) {
                    bf16x8 kb0, kb1, af[5];
                    const int sr = 32 * jj + 4 * fq + (fr >> 2);
                    kb0 = tr_pair(Ks + sr * MQ_STRIDE + (16 * wid + 4 * (fr & 3)) * 2, Ks + (sr + 16) * MQ_STRIDE + (16 * wid + 4 * (fr & 3)) * 2);
                    kb1 = kb0;
                    if (nown == 2) kb1 = tr_pair(Ks + sr * MQ_STRIDE + (16 * (wid + 6) + 4 * (fr & 3)) * 2, Ks + (sr + 16) * MQ_STRIDE + (16 * (wid + 6) + 4 * (fr & 3)) * 2);
#pragma unroll
                    for (int dt = 0; dt < 5; ++dt) af[dt] = tr_pair(VWs + sr * MV_STRIDE + (16 * dt + 4 * (fr & 3)) * 2, VWs + (sr + 16) * MV_STRIDE + (16 * dt + 4 * (fr & 3)) * 2);
                    __builtin_amdgcn_sched_barrier(0);
#pragma unroll
                    for (int dt = 0; dt < 5; ++dt) Creg[0][dt] = __builtin_amdgcn_mfma_f32_16x16x32_bf16(af[dt], kb0, Creg[0][dt], 0, 0, 0);
                    if (nown == 2) {
#pragma unroll
                        for (int dt = 0; dt < 5; ++dt) Creg[1][dt] = __builtin_amdgcn_mfma_f32_16x16x32_bf16(af[dt], kb1, Creg[1][dt], 0, 0, 0);
                    }
                    __builtin_amdgcn_sched_barrier(0);
                }
            }
            if (wid == 2 && c + 1 < nc) GATES(cur ^ 1);
            LBAR();
            if (nown > 0) {
#pragma unroll
                for (int dt = 0; dt < 5; ++dt)
#pragma unroll
                    for (int i = 0; i < 4; ++i)
                        *(LAS bf16_t*)(Cs + (16 * dt + 4 * fq + i) * MQ_STRIDE + (16 * wid + fr) * 2) = (bf16_t)(pk2(Creg[0][dt][i], 0.f) & 0xffffu);
                if (nown == 2) {
#pragma unroll
                    for (int dt = 0; dt < 5; ++dt)
#pragma unroll
                        for (int i = 0; i < 4; ++i)
                            *(LAS bf16_t*)(Cs + (16 * dt + 4 * fq + i) * MQ_STRIDE + (16 * (wid + 6) + fr) * 2) = (bf16_t)(pk2(Creg[1][dt][i], 0.f) & 0xffffu);
                }
            }
        }
#undef MLOAD
#undef GLOAD
#undef GATES
#undef MTOK
    }
    LBAR();
}

DI void mlstm_combine_phase(bf16_t* Hfw, const bf16_t* Hbw, const bf16_t* proj, const float* hn, int G, int bid) {
    int tid_ = threadIdx.x; asm volatile("" : "+v"(tid_)); asm volatile("" : "+s"(bid)); const int tid = tid_, wid = tid >> 6, lane = tid & 63;
    const int gw = bid * 8 + wid, NGW = G * 8;
    for (int row = gw; row < T; row += NGW) {
        u32x4 f[2], b[2], o[2];
#pragma unroll
        for (int q = 0; q < 2; ++q) {
            f[q] = __builtin_nontemporal_load((const u32x4*)(Hfw + (size_t)row * D + q * 512 + 8 * lane));
            b[q] = __builtin_nontemporal_load((const u32x4*)(Hbw + (size_t)row * D + q * 512 + 8 * lane));
            o[q] = __builtin_nontemporal_load((const u32x4*)(proj + (size_t)row * NPROJ + 2048 + q * 512 + 8 * lane));
        }
#pragma unroll
        for (int q = 0; q < 2; ++q) {
            float hs[8], ov[8]; float ss = 0.f;
#pragma unroll
            for (int i = 0; i < 4; ++i) {
                hs[2 * i] = bflo(f[q][i]) + bflo(b[q][i]); hs[2 * i + 1] = bfhi(f[q][i]) + bfhi(b[q][i]);
                ov[2 * i] = bflo(o[q][i]); ov[2 * i + 1] = bfhi(o[q][i]);
            }
#pragma unroll
            for (int i = 0; i < 8; ++i) ss += hs[i] * hs[i];
            ss += __shfl_xor(ss, 1); ss += __shfl_xor(ss, 2); ss += __shfl_xor(ss, 4); ss += __shfl_xor(ss, 8); ss += __shfl_xor(ss, 16);
            const float rstd = rsqrtf(ss * (1.0f / 256.0f) + RMS_EPS);
            const float* hp = hn + q * 512 + 8 * lane;
            u32x4 w;
#pragma unroll
            for (int i = 0; i < 4; ++i) {
                const float y0 = hs[2 * i] * rstd * hp[2 * i] / (1.0f + __expf(-ov[2 * i]));
                const float y1 = hs[2 * i + 1] * rstd * hp[2 * i + 1] / (1.0f + __expf(-ov[2 * i + 1]));
                w[i] = pk2(y0, y1);
            }
            *(u32x4*)(Hfw + (size_t)row * D + q * 512 + 8 * lane) = w;
        }
    }
}

#define XB_TMO      128
#define XB_XCNT(j)  (256  + 64 * (j))
#define XB_XSUB(j)  (1280 + 64 * (j))
#define XB_XGEN(j)  (2304 + 64 * (j))
#define XB_TOP      3328
#define XB_TOPGEN   3392
#define XCD_BAR_WORDS 3456
#define XB_SPIN_CAP (1u << 18)
DI unsigned xb_ld(unsigned* p)              { return __hip_atomic_load(p, __ATOMIC_RELAXED, __HIP_MEMORY_SCOPE_AGENT); }
DI unsigned xb_add(unsigned* p, unsigned v) { return __hip_atomic_fetch_add(p, v, __ATOMIC_RELAXED, __HIP_MEMORY_SCOPE_AGENT); }
DI unsigned xb_xcc_id() { return (unsigned)__builtin_amdgcn_s_getreg((3 << 11) | 20) & 0xFu; }
#define XB_SPIN(cond, bar) do { unsigned _sp = 0; while (cond) { __builtin_amdgcn_s_sleep(1); \
    if ((++_sp & 255u) == 0u) { if (xb_ld(&(bar)[XB_TMO])) break; if (_sp > XB_SPIN_CAP) { atomicAdd(&(bar)[XB_TMO], 1u); break; } } } } while (0)
struct XcdBarrier { unsigned* bar; unsigned x; volatile LAS unsigned* st; };
DI XcdBarrier xcd_barrier_post(unsigned* bar, volatile LAS unsigned* st) {
    XcdBarrier b; b.bar = bar; b.x = xb_xcc_id(); b.st = st;
    if (threadIdx.x == 0) (void)xb_add(&bar[XB_XCNT(b.x)], 1u);
    return b;
}
DI void xcd_barrier_complete(unsigned* bar, unsigned x, unsigned& nloc, unsigned& nx) {
    const unsigned G = gridDim.x * gridDim.y * gridDim.z;
    unsigned sum, cnt, mine, sp = 0u;
    for (;;) {
        sum = 0u; cnt = 0u; mine = 0u;
#pragma unroll
        for (unsigned j = 0; j < 16; ++j) { const unsigned c = xb_ld(&bar[XB_XCNT(j)]); sum += c; cnt += (c > 0u) ? 1u : 0u; mine = (j == x) ? c : mine; }
        if (sum == G) break;
        __builtin_amdgcn_s_sleep(1);
        if ((++sp & 255u) == 0u) { if (xb_ld(&bar[XB_TMO])) break; if (sp > XB_SPIN_CAP) { atomicAdd(&bar[XB_TMO], 1u); break; } }
    }
    nloc = mine > 0u ? mine : 1u; nx = cnt > 0u ? cnt : 1u;
}
DI void xcd_barrier(const XcdBarrier& b) {
    asm volatile("s_waitcnt vmcnt(0)" ::: "memory");
    __syncthreads();
    if (threadIdx.x == 0) {
        unsigned* bar = b.bar;
        __builtin_amdgcn_s_waitcnt(0);
        unsigned nloc = b.st[0], nx = b.st[1];
        if (nloc == 0u) { xcd_barrier_complete(bar, b.x, nloc, nx); b.st[0] = nloc; b.st[1] = nx; }
        const unsigned old = xb_add(&bar[XB_XSUB(b.x)], 1u);
        const unsigned gen = old / nloc;
        if (old + 1u == (gen + 1u) * nloc) {
            __builtin_amdgcn_fence(__ATOMIC_RELEASE, "agent");
            asm volatile("s_waitcnt vmcnt(0)" ::: "memory");
            const unsigned og = xb_add(&bar[XB_TOP], 1u);
            const unsigned tg = og / nx;
            if (og + 1u == (tg + 1u) * nx) xb_add(&bar[XB_TOPGEN], 1u);
            else XB_SPIN(xb_ld(&bar[XB_TOPGEN]) == tg, bar);
            __builtin_amdgcn_fence(__ATOMIC_ACQUIRE, "agent");
            xb_add(&bar[XB_XGEN(b.x)], 1u);
            asm volatile("s_waitcnt vmcnt(0)" ::: "memory");
        } else {
            XB_SPIN(xb_ld(&bar[XB_XGEN(b.x)]) == gen, bar);
            __builtin_amdgcn_fence(__ATOMIC_ACQUIRE, "agent");
            asm volatile("s_waitcnt vmcnt(0)" ::: "memory");
        }
    }
    __syncthreads();
}

__global__ void __launch_bounds__(512, 2) fwd_megakernel(Args args) {
    extern __shared__ __attribute__((aligned(16))) unsigned char lds_raw[];
    LAS unsigned char* lds = (LAS unsigned char*)lds_raw;
    cg::grid_group grid = cg::this_grid();
    if (threadIdx.x < 16) ((LAS unsigned*)(lds + LDS_BYTES - 64))[threadIdx.x] = 0u;
    __syncthreads();
    const XcdBarrier xbar = xcd_barrier_post((unsigned*)(args.ws + WS_BAR), (volatile LAS unsigned*)(lds + LDS_BYTES - 64));
    const int G = gridDim.x, bid = blockIdx.x;
    unsigned char* ws = args.ws;
    float* mod = (float*)(ws + WS_MOD);
    float* xout = args.out;
    const float* xin_p = args.in[0]; const float* xin_s = args.in[1] - (size_t)TP * D;

#ifndef REP_GEMM
#define REP_GEMM 1
#endif
#ifndef REP_MLSTM
#define REP_MLSTM 1
#endif
#ifndef REP_NORM
#define REP_NORM 1
#endif
#define GEMM_PHASE(MODE, Aptr, Bptr, LDA, KK, NN, EPI) do { pg8::Gemm gm{(const bf16_t*)(Aptr), (const bf16_t*)(Bptr), (LDA), (KK), T, (NN)}; pg8::StaticOrder S; S.init(T, (NN), G, bid); \
        pg8::gemm_phase<MODE>(lds, gm, S, EPI); } while (0)
    const float* rope = (const float*)(ws + WS_ROPE);
    float* mod1 = mod + 16 * 6144;
    unsigned long long* rowq = (unsigned long long*)(ws + WS_ROWQ);
    float* lse = xout + OUT_LSE / 4;
#define EPI0(O_, ROPE_) pg8::Epi{(O_), (ROPE_), nullptr, nullptr, nullptr, nullptr, nullptr, nullptr, nullptr, nullptr, nullptr, nullptr, nullptr, nullptr, nullptr, 0}
#define EPI1(BP, BS, GT, ID, NG, NSH, NSC, HOUT, FIN) pg8::Epi{nullptr, nullptr, (BP), (BS), xout, (GT), nullptr, nullptr, nullptr, nullptr, rowq + (size_t)(ID) * T, (NG), (NSH), (NSC), (HOUT), (FIN)}
#ifdef PROBE_SYNC
    for (int i = 0; i < 20; ++i) grid.sync();
#endif
    prologue(lds, args, G, bid);
    if (G == 0x7fffffff) grid.sync();
    xcd_barrier(xbar);
    for (int rep = 0; rep < REP_NORM; ++rep) { normmod_phase(xin_p, xin_s, args.in[6], mod + 0, mod + 1024, (bf16_t*)xout, G, bid); if (rep + 1 < REP_NORM) xcd_barrier(xbar); }
    xcd_barrier(xbar);
    { pg8::Epi E = EPI0((bf16_t*)(ws + WS_R), rope);
      for (int rep = 0; rep < REP_GEMM; ++rep) { GEMM_PHASE(0, xout, ws + WS_WQKV, D, D, NQKV, E); if (rep + 1 < REP_GEMM) xcd_barrier(xbar); } }
    xcd_barrier(xbar);
    attn_phase(lds, (bf16_t*)(ws + WS_R), lse, G, bid);
    xcd_barrier(xbar);
    for (int rep = 0; rep < REP_NORM; ++rep) { attn_combine_phase((const bf16_t*)(ws + WS_R), lse, (bf16_t*)(ws + WS_Y), G, bid); if (rep + 1 < REP_NORM) xcd_barrier(xbar); }
    xcd_barrier(xbar);
    { pg8::Epi E = EPI1(xin_p, xin_s, mod + 2048, 0, args.in[9], mod + 3072, mod + 4096, (bf16_t*)(ws + WS_R), 0);
      GEMM_PHASE(1, ws + WS_Y, ws + WS_WO, 512, 512, D, E); }
    xcd_barrier(xbar);
    { pg8::Epi E = EPI0((bf16_t*)(ws + WS_B), nullptr);
      for (int rep = 0; rep < REP_GEMM; ++rep) { GEMM_PHASE(2, ws + WS_R, ws + WS_WGU0, D, D, NGU, E); if (rep + 1 < REP_GEMM) xcd_barrier(xbar); } }
    xcd_barrier(xbar);
    { pg8::Epi E = EPI1(xout, xout, mod + 5120, 1, args.in[14], mod1 + 0, mod1 + 1024, (bf16_t*)(ws + WS_R), 0);
      GEMM_PHASE(1, ws + WS_B, ws + WS_WDN0, FFH, FFH, D, E); }
    xcd_barrier(xbar);
    { pg8::Epi E = EPI0((bf16_t*)(ws + WS_B), nullptr); E.gates = (float*)(ws + WS_GATES); E.bg = args.in[16]; E.A3 = (const bf16_t*)(ws + WS_R); E.Wg = (const bf16_t*)(ws + WS_WIN) + (size_t)NPROJ * D;
      for (int rep = 0; rep < REP_GEMM; ++rep) { GEMM_PHASE(3, ws + WS_R, ws + WS_WIN, D, D, NPROJ, E); if (rep + 1 < REP_GEMM) xcd_barrier(xbar); } }
    xcd_barrier(xbar);
    for (int rep = 0; rep < REP_MLSTM; ++rep) { mlstm_phase(lds, (const bf16_t*)(ws + WS_B), (const float*)(ws + WS_GATES), (bf16_t*)(ws + WS_R), (bf16_t*)(ws + WS_HBW), G, bid); if (rep + 1 < REP_MLSTM) xcd_barrier(xbar); }
    xcd_barrier(xbar);
    mlstm_combine_phase((bf16_t*)(ws + WS_R), (const bf16_t*)(ws + WS_HBW), (const bf16_t*)(ws + WS_B), args.in[17], G, bid);
    xcd_barrier(xbar);
    { pg8::Epi E = EPI1(xout, xout, mod1 + 2048, 2, args.in[19], mod1 + 3072, mod1 + 4096, (bf16_t*)(ws + WS_B), 0);
      GEMM_PHASE(1, ws + WS_R, ws + WS_WOUT, D, D, D, E); }
    xcd_barrier(xbar);
    { pg8::Epi E = EPI0((bf16_t*)(ws + WS_HID1), nullptr);
      for (int rep = 0; rep < REP_GEMM; ++rep) { GEMM_PHASE(2, ws + WS_B, ws + WS_WGU1, D, D, NGU, E); if (rep + 1 < REP_GEMM) xcd_barrier(xbar); } }
    xcd_barrier(xbar);
    { pg8::Epi E = EPI1(xout, xout, mod1 + 5120, 3, args.in[22], nullptr, nullptr, nullptr, 1);
      GEMM_PHASE(1, ws + WS_HID1, ws + WS_WDN1, FFH, FFH, D, E); }
}

extern "C" void kernel_launch(void* const* d_in, const int* in_sizes, int n_in, void* d_out, int out_size, void* d_ws, size_t ws_size, hipStream_t stream) {
    static int grid = 0;
    if (grid == 0) {
        if (n_in != 23 || out_size != T * D || ws_size < WS_NEED) { fprintf(stderr, "kernel_launch: unexpected shapes (n_in %d out %d ws %zu)\n", n_in, out_size, ws_size); grid = -1; return; }
        int dev = 0, cus = 0, per_cu = 0;
        hipGetDevice(&dev);
        hipDeviceGetAttribute(&cus, hipDeviceAttributeMultiprocessorCount, dev);
        hipFuncSetAttribute((const void*)fwd_megakernel, hipFuncAttributeMaxDynamicSharedMemorySize, LDS_BYTES);
        hipOccupancyMaxActiveBlocksPerMultiprocessor(&per_cu, (const void*)fwd_megakernel, 512, LDS_BYTES);
        if (per_cu < 1) per_cu = 1;
        grid = cus * per_cu;
        (void)hipGetLastError();
    }
    if (grid < 0) return;
    hipMemsetAsync((char*)d_ws + WS_MOD, 0, WS_ZERO_BYTES, stream);
    Args a{};
    for (int i = 0; i < 23; ++i) a.in[i] = (const float*)d_in[i];
    a.out = (float*)d_out; a.ws = (unsigned char*)d_ws;
    void* kargs[] = {&a};
    hipError_t e = hipLaunchCooperativeKernel((const void*)fwd_megakernel, dim3(grid), dim3(512), kargs, LDS_BYTES, stream);
    if (e != hipSuccess) fprintf(stderr, "cooperative launch failed: %s (grid %d)\n", hipGetErrorString(e), grid);
}
```
